# Optimizing an MI355X kernel written in HIP

```python
import math
import jax, jax.numpy as jnp
from jax import lax
import numpy as np


D_MODEL = 4096
BATCH = 4
SEQ = 4096
DEPTH = 2
DEC_BATCH = 16
DEC_SEQ = 16
PAST_LEN = 1024

CHUNK = 64
QBLOCK = 128
D_MIX = D_MODEL
D_SSM = D_MIX // 2
SSM_HEAD_DIM = 64
N_SSM_HEADS = D_SSM // SSM_HEAD_DIM
N_SSM_GROUPS = 4
D_STATE = 128
CONV_W = 4
D_CONV = D_SSM + 2 * N_SSM_GROUPS * D_STATE
D_DIFF = D_MIX // 4
N_DIFF_HEADS = 4
DIFF_HEAD_DIM = D_DIFF // (2 * N_DIFF_HEADS)
D_MEM = D_MIX - D_SSM - D_DIFF
N_MEM_HEADS = 4
MEM_HEAD_DIM = D_MEM // N_MEM_HEADS
N_MEM = 256
NORM_EPS = 1e-6
SUBLN_EPS = 1e-5
IN_SIZES = (D_SSM, D_CONV, N_SSM_HEADS, D_DIFF, D_DIFF, D_DIFF, D_DIFF, D_MEM, D_MEM)
IN_SPLITS = tuple(int(s) for s in np.cumsum(IN_SIZES)[:-1])
D_IN = sum(IN_SIZES)

kernel_name = 'hybrid_ssd_diffattn_memory_streaming_step'


def rmsnorm(x, w, eps=NORM_EPS):
    xf = x.astype(jnp.float32)
    y = xf * lax.rsqrt(jnp.mean(xf * xf, axis=-1, keepdims=True) + eps)
    return (y * w.astype(jnp.float32)).astype(x.dtype)


def causal_conv(xp, w, b, length):
    out = b
    for j in range(CONV_W):
        out = out + xp[:, j:j + length] * w[j]
    return out


def ssd_scan(x, dt, a, bm, cm, h0):
    bsz, length, n_heads, p_dim = x.shape
    g_n, n_st = bm.shape[2], bm.shape[3]
    r_n = n_heads // g_n
    q_len = min(CHUNK, length)
    nc = length // q_len
    xd = (x.astype(jnp.float32) * dt[..., None]).reshape(bsz, nc, q_len, g_n, r_n, p_dim)
    da = (dt * a).reshape(bsz, nc, q_len, g_n, r_n).transpose(0, 3, 4, 1, 2)
    bc = bm.reshape(bsz, nc, q_len, g_n, n_st)
    cc = cm.reshape(bsz, nc, q_len, g_n, n_st)
    cum = jnp.cumsum(da, axis=-1)
    causal = jnp.tril(jnp.ones((q_len, q_len), dtype=bool))
    seg = cum[..., :, None] - cum[..., None, :]
    lmat = jnp.exp(jnp.where(causal, seg, -jnp.inf))
    cb = jnp.einsum('bclgn,bcsgn->bgcls', cc, bc)
    y_diag = jnp.einsum('bgrcls,bcsgrp->bclgrp', cb[:, :, None] * lmat, xd)
    decay_st = jnp.exp(cum[..., -1:] - cum)
    states = jnp.einsum('bclgn,bgrcl,bclgrp->cbgrpn', bc, decay_st, xd)
    chunk_decay = jnp.exp(cum[..., -1]).transpose(3, 0, 1, 2)

    def step(h, inp):
        st, dc = inp
        return h * dc[..., None, None] + st, h

    h_init = h0.astype(jnp.float32).reshape(bsz, g_n, r_n, p_dim, n_st)
    h_last, h_prev = lax.scan(step, h_init, (states, chunk_decay))
    y_off = jnp.einsum('bclgn,cbgrpn,bgrcl->bclgrp', cc, h_prev, jnp.exp(cum))
    y = (y_diag + y_off).reshape(bsz, length, n_heads, p_dim)
    return y, h_last.reshape(bsz, n_heads, p_dim, n_st)


def diff_attention(q, k, v, q_start, lam, subln_w, lambda_init):
    bsz, lq = q.shape[0], q.shape[1]
    lk = k.shape[1]
    qb = min(QBLOCK, lq)
    nb = lq // qb
    k_chunk = jnp.arange(lk) // CHUNK
    scale = DIFF_HEAD_DIM ** -0.5

    def block(args):
        qi, start = args
        q_chunk = (q_start + start + jnp.arange(qb)) // CHUNK
        s = jnp.einsum('bqhmd,bkhmd->bhmqk', qi, k).astype(jnp.float32) * scale
        mask = k_chunk[None, :] <= q_chunk[:, None]
        s = jnp.where(mask, s, -jnp.inf)
        pr = jax.nn.softmax(s, axis=-1)
        wgt = pr[:, :, 0] - lam * pr[:, :, 1]
        return jnp.einsum('bhqk,bkhe->bqhe', wgt, v)

    qs = q.reshape(bsz, nb, qb, N_DIFF_HEADS, 2, DIFF_HEAD_DIM).transpose(1, 0, 2, 3, 4, 5)
    o = lax.map(block, (qs, jnp.arange(nb) * qb))
    o = o.transpose(1, 0, 2, 3, 4).reshape(bsz, lq, N_DIFF_HEADS, 2 * DIFF_HEAD_DIM)
    o = rmsnorm(o, subln_w, SUBLN_EPS) * (1.0 - lambda_init)
    return o.astype(q.dtype)


def mem_attention(q, mk, mv):
    s = jnp.einsum('bqhd,bkhd->bhqk', q, mk).astype(jnp.float32) * (MEM_HEAD_DIM ** -0.5)
    pr = jax.nn.softmax(s, axis=-1)
    return jnp.einsum('bhqk,bkhd->bqhd', pr, mv).astype(q.dtype)


def mixer_layer(x, conv_hist, h0, k_past, v_past, mem_k, mem_v, p, lambda_init):
    bsz, length, _ = x.shape
    h = rmsnorm(x, p['norm_pre_w'])
    proj = h @ p['w_in']
    z, xbc, dt_raw, q_d, k_d, v_d, g_d, q_m, g_m = jnp.split(proj, IN_SPLITS, axis=-1)
    xp = jnp.concatenate([conv_hist.astype(xbc.dtype), xbc], axis=1)
    new_conv = xp[:, length:]
    xbc_c = jax.nn.silu(causal_conv(xp, p['conv_w'], p['conv_b'], length))
    xs, bs, cs = jnp.split(xbc_c, [D_SSM, D_SSM + N_SSM_GROUPS * D_STATE], axis=-1)
    xs = xs.reshape(bsz, length, N_SSM_HEADS, SSM_HEAD_DIM)
    bs = bs.reshape(bsz, length, N_SSM_GROUPS, D_STATE)
    cs = cs.reshape(bsz, length, N_SSM_GROUPS, D_STATE)
    dt = jax.nn.softplus(dt_raw.astype(jnp.float32) + p['dt_bias'].astype(jnp.float32))
    a = -jnp.exp(p['a_log'].astype(jnp.float32))
    y_s, h_new = ssd_scan(xs, dt, a, bs, cs, h0)
    y_s = y_s + xs.astype(jnp.float32) * p['d_skip'].astype(jnp.float32)[:, None]
    y_s = y_s.reshape(bsz, length, D_SSM) * jax.nn.silu(z.astype(jnp.float32))
    y_s = rmsnorm(y_s.reshape(bsz, length, N_SSM_GROUPS, D_SSM // N_SSM_GROUPS),
                  p['ssm_norm_w'].reshape(N_SSM_GROUPS, D_SSM // N_SSM_GROUPS))
    y_s = y_s.reshape(bsz, length, D_SSM).astype(x.dtype)
    q = q_d.reshape(bsz, length, N_DIFF_HEADS, 2, DIFF_HEAD_DIM)
    k = k_d.reshape(bsz, length, N_DIFF_HEADS, 2, DIFF_HEAD_DIM)
    v = v_d.reshape(bsz, length, N_DIFF_HEADS, 2 * DIFF_HEAD_DIM)
    if k_past is None:
        keys, vals, q_start = k, v, 0
    else:
        keys = jnp.concatenate([k_past.astype(k.dtype), k], axis=1)
        vals = jnp.concatenate([v_past.astype(v.dtype), v], axis=1)
        q_start = k_past.shape[1]
    lam = (jnp.exp(jnp.sum(p['lambda_q1'].astype(jnp.float32) * p['lambda_k1'].astype(jnp.float32)))
           - jnp.exp(jnp.sum(p['lambda_q2'].astype(jnp.float32) * p['lambda_k2'].astype(jnp.float32)))
           + lambda_init)
    y_d = diff_attention(q, keys, vals, q_start, lam, p['subln_w'], lambda_init)
    y_d = y_d.reshape(bsz, length, D_DIFF) * jax.nn.silu(g_d)
    y_m = mem_attention(q_m.reshape(bsz, length, N_MEM_HEADS, MEM_HEAD_DIM), mem_k.astype(q_m.dtype), mem_v.astype(q_m.dtype))
    y_m = y_m.reshape(bsz, length, D_MEM) * jax.nn.silu(g_m)
    out = jnp.concatenate([y_s, y_d, y_m], axis=-1) @ p['w_out']
    x = x + rmsnorm(out, p['norm_post_w'])
    return x, new_conv, h_new, k, v


def setup_inputs(seed: int = 0) -> dict:
    key = jax.random.key(seed)
    ks = jax.random.split(key, 32)
    f32 = jnp.float32

    def nrm(k, shape, s):
        return jax.random.normal(k, shape, f32) * s

    dt0 = jnp.exp(jax.random.uniform(ks[14], (DEPTH, N_SSM_HEADS), f32, math.log(1e-3), math.log(1e-1)))
    return {
        'x_prompt': nrm(ks[0], (BATCH, SEQ, D_MODEL), 1.0),
        'x_sample': nrm(ks[1], (DEC_BATCH, DEC_SEQ, D_MODEL), 1.0),
        'mem_prompt': nrm(ks[2], (BATCH, N_MEM, D_MODEL), 1.0),
        'cache_conv': nrm(ks[3], (DEPTH, DEC_BATCH, CONV_W - 1, D_CONV), 1.0),
        'state_ssm': nrm(ks[4], (DEPTH, DEC_BATCH, N_SSM_HEADS, SSM_HEAD_DIM, D_STATE), 0.1),
        'cache_k': nrm(ks[5], (DEPTH, DEC_BATCH, PAST_LEN, N_DIFF_HEADS, 2, DIFF_HEAD_DIM), 1.0),
        'cache_v': nrm(ks[6], (DEPTH, DEC_BATCH, PAST_LEN, N_DIFF_HEADS, 2 * DIFF_HEAD_DIM), 1.0),
        'cache_mem_k': nrm(ks[7], (DEPTH, DEC_BATCH, N_MEM, N_MEM_HEADS, MEM_HEAD_DIM), 1.0),
        'cache_mem_v': nrm(ks[8], (DEPTH, DEC_BATCH, N_MEM, N_MEM_HEADS, MEM_HEAD_DIM), 1.0),
        'norm_pre_w': 1.0 + nrm(ks[9], (DEPTH, D_MODEL), 0.01),
        'norm_post_w': 1.0 + nrm(ks[10], (DEPTH, D_MODEL), 0.01),
        'w_in': nrm(ks[11], (DEPTH, D_MODEL, D_IN), D_MODEL ** -0.5),
        'conv_w': nrm(ks[12], (DEPTH, CONV_W, D_CONV), CONV_W ** -0.5),
        'conv_b': nrm(ks[13], (DEPTH, D_CONV), 0.01),
        'dt_bias': dt0 + jnp.log(-jnp.expm1(-dt0)),
        'a_log': jnp.log(jax.random.uniform(ks[15], (DEPTH, N_SSM_HEADS), f32, 1.0, 16.0)),
        'd_skip': 1.0 + nrm(ks[16], (DEPTH, N_SSM_HEADS), 0.01),
        'ssm_norm_w': 1.0 + nrm(ks[17], (DEPTH, D_SSM), 0.01),
        'lambda_q1': nrm(ks[18], (DEPTH, DIFF_HEAD_DIM), 0.1),
        'lambda_k1': nrm(ks[19], (DEPTH, DIFF_HEAD_DIM), 0.1),
        'lambda_q2': nrm(ks[20], (DEPTH, DIFF_HEAD_DIM), 0.1),
        'lambda_k2': nrm(ks[21], (DEPTH, DIFF_HEAD_DIM), 0.1),
        'subln_w': 1.0 + nrm(ks[22], (DEPTH, 2 * DIFF_HEAD_DIM), 0.01),
        'mem_norm_w': 1.0 + nrm(ks[23], (DEPTH, D_MODEL), 0.01),
        'w_mem_kv': nrm(ks[24], (DEPTH, D_MODEL, 2 * D_MEM), D_MODEL ** -0.5),
        'w_out': nrm(ks[25], (DEPTH, D_MIX, D_MODEL), D_MIX ** -0.5),
    }


def reference(x_prompt, x_sample, mem_prompt, cache_conv, state_ssm, cache_k, cache_v,
              cache_mem_k, cache_mem_v, norm_pre_w, norm_post_w, w_in, conv_w, conv_b,
              dt_bias, a_log, d_skip, ssm_norm_w, lambda_q1, lambda_k1, lambda_q2, lambda_k2,
              subln_w, mem_norm_w, w_mem_kv, w_out):
    bsz_p = x_prompt.shape[0]
    xp_ = x_prompt
    xs_ = x_sample
    p_conv, p_ssm, p_k, p_v, p_mk, p_mv = [], [], [], [], [], []
    s_conv, s_ssm, s_k, s_v = [], [], [], []
    for l in range(DEPTH):
        prm = {
            'norm_pre_w': norm_pre_w[l], 'norm_post_w': norm_post_w[l], 'w_in': w_in[l],
            'conv_w': conv_w[l], 'conv_b': conv_b[l], 'dt_bias': dt_bias[l], 'a_log': a_log[l],
            'd_skip': d_skip[l], 'ssm_norm_w': ssm_norm_w[l], 'lambda_q1': lambda_q1[l],
            'lambda_k1': lambda_k1[l], 'lambda_q2': lambda_q2[l], 'lambda_k2': lambda_k2[l],
            'subln_w': subln_w[l], 'w_out': w_out[l],
        }
        lambda_init = 0.8 - 0.6 * math.exp(-0.3 * l)
        mkv = rmsnorm(mem_prompt, mem_norm_w[l]) @ w_mem_kv[l]
        mk_p, mv_p = jnp.split(mkv, 2, axis=-1)
        mk_p = mk_p.reshape(bsz_p, N_MEM, N_MEM_HEADS, MEM_HEAD_DIM)
        mv_p = mv_p.reshape(bsz_p, N_MEM, N_MEM_HEADS, MEM_HEAD_DIM)
        conv0 = jnp.zeros((bsz_p, CONV_W - 1, D_CONV), x_prompt.dtype)
        h_zero = jnp.zeros((bsz_p, N_SSM_HEADS, SSM_HEAD_DIM, D_STATE), jnp.float32)
        xp_, c_p, h_p, k_p, v_p = mixer_layer(xp_, conv0, h_zero, None, None, mk_p, mv_p, prm, lambda_init)
        xs_, c_s, h_s, k_s, v_s = mixer_layer(xs_, cache_conv[l], state_ssm[l], cache_k[l], cache_v[l],
                                             cache_mem_k[l], cache_mem_v[l], prm, lambda_init)
        p_conv.append(c_p); p_ssm.append(h_p); p_k.append(k_p); p_v.append(v_p)
        p_mk.append(mk_p); p_mv.append(mv_p)
        s_conv.append(c_s); s_ssm.append(h_s); s_k.append(k_s); s_v.append(v_s)
    return (xp_, xs_, jnp.stack(p_conv), jnp.stack(p_ssm), jnp.stack(p_k), jnp.stack(p_v),
            jnp.stack(p_mk), jnp.stack(p_mv), jnp.stack(s_conv), jnp.stack(s_ssm),
            jnp.stack(s_k), jnp.stack(s_v))
```

```cpp
#include <hip/hip_runtime.h>
#include <cstdio>
#include <cstdint>

#ifndef MK_ONE_LAUNCH
#define MK_ONE_LAUNCH 1
#endif
#ifndef MK_SKIP
#define MK_SKIP 0
#endif
#ifndef MK_PROBE_LD
#define MK_PROBE_LD 0
#endif
#ifndef MK_DUP
#define MK_DUP 0
#endif
#ifndef MK_DUPA
#define MK_DUPA 0
#endif

namespace pg8 {
#define PG8_LAS __attribute__((address_space(3)))
typedef unsigned short bf16_t;
typedef short bf16x8 __attribute__((ext_vector_type(8)));
typedef float f32x4 __attribute__((ext_vector_type(4)));
typedef unsigned u32x4 __attribute__((ext_vector_type(4)));
constexpr int BM = 256, BK = 64, HALF = 128, HTB = HALF * BK * 2  , STAGE_BYTES = 8 * HTB, NXCD = 8, WGM = 8;

__host__ __device__ __forceinline__ int lds_byte(int r, int c) { return (r >> 3) * 1024 + (r & 7) * 128 + ((((c >> 3) ^ r) & 7) << 4) + (c & 7) * 2; }
__host__ __device__ __forceinline__ void stage_rc(int b, int& R, int& C) { const int rr = (b >> 7) & 7; R = (b >> 10) * 8 + rr; C = (((b >> 4) ^ rr) & 7) << 3; }
__host__ __device__ __forceinline__ int perm32(int rho) { const int n = rho >> 4, i = rho & 15; return 8 * (i >> 2) + 4 * n + (i & 3); }

struct Unit { int pm, pn, kb; };
struct Gemm { const bf16_t* A; const bf16_t* Bt; int ld, K; };

__host__ __device__ __forceinline__ void rect_tile(int wgid, int nM, int nN, int& pm, int& pn) {
    const int nwg = nM * nN;
    { const int q = nwg / NXCD, r = nwg % NXCD, xcd = wgid % NXCD, off = wgid / NXCD; wgid = (xcd < r ? xcd * (q + 1) : r * (q + 1) + (xcd - r) * q) + off; }
    const int nig = WGM * nN, gid = wgid / nig, fm = gid * WGM, gsz = (nM - fm) < WGM ? (nM - fm) : WGM;
    pm = fm + ((wgid % nig) % gsz); pn = (wgid % nig) / gsz;
}

template <class Epi, class Sched>
__device__ __forceinline__ void gemm_phase(PG8_LAS unsigned char* lds, const Gemm g, const Sched& S, const Epi& E, const int tid) {
    const int wid = __builtin_amdgcn_readfirstlane(tid >> 6), lane = tid & 63, wr = wid >> 2, wc = wid & 3, fr = lane & 15, fq = lane >> 4;
    const int ld = g.ld, nt = g.K / BK;
    unsigned voffA[2], voffB[2];
#pragma unroll
    for (int i = 0; i < 2; ++i) { int R, C; stage_rc(tid * 16 + i * 8192, R, C); const int Rb = Epi::PERM ? ((R & ~31) + perm32(R & 31)) : R;
        voffA[i] = (unsigned)(R * ld + C) * 2u; voffB[i] = (unsigned)(Rb * ld + C) * 2u; }
    const size_t kstep = (size_t)(BK * 2);
    const size_t hstep = (size_t)HALF * ld * 2;
    const size_t tstep = 2 * hstep;
    const unsigned ldsw = (unsigned)wid * 1024u;
    const int aoff = lds_byte(wr * 64 + fr, fq * 8), boff = lds_byte(wc * 32 + fr, fq * 8);
#define PG8_SA(b, h) (((b) * 2 + (h)) * HTB)
#define PG8_SB(b, h) ((4 + (b) * 2 + (h)) * HTB)
#define PG8_STAGE(bufoff, gbase, voff) do { _Pragma("unroll") for (int _i = 0; _i < 2; ++_i) { unsigned _vo = (voff)[_i]; asm volatile("" : "+v"(_vo));     \
        __builtin_amdgcn_global_load_lds((const unsigned*)((const char*)(gbase) + _vo), (PG8_LAS unsigned*)(lds + (bufoff) + ldsw + _i * 8192), 16, 0, 0); } } while (0)
#define PG8_LDA(dst, b, h) do { int a1_ = aoff ^ 64; asm volatile("" : "+v"(a1_));     \
        _Pragma("unroll") for (int m = 0; m < 4; ++m) { dst[m][0] = *(const PG8_LAS bf16x8*)(lds + PG8_SA(b, h) + aoff + m * 2048); dst[m][1] = *(const PG8_LAS bf16x8*)(lds + PG8_SA(b, h) + a1_ + m * 2048); } } while (0)
#define PG8_LDB(dst, b, h) do { int b1_ = boff ^ 64; asm volatile("" : "+v"(b1_)); \
        _Pragma("unroll") for (int n = 0; n < 2; ++n) { dst[n][0] = *(const PG8_LAS bf16x8*)(lds + PG8_SB(b, h) + boff + n * 2048); dst[n][1] = *(const PG8_LAS bf16x8*)(lds + PG8_SB(b, h) + b1_ + n * 2048); } } while (0)
#define PG8_MMA(ai, bj, At, Bt) do { __builtin_amdgcn_s_setprio(1); _Pragma("unroll") for (int m = 0; m < 4; ++m) _Pragma("unroll") for (int n = 0; n < 2; ++n) _Pragma("unroll") for (int k = 0; k < 2; ++k) \
        acc[ai][bj][m][n] = __builtin_amdgcn_mfma_f32_16x16x32_bf16(Bt[n][k], At[m][k], acc[ai][bj][m][n], 0, 0, 0); __builtin_amdgcn_s_setprio(0); } while (0)
#define PG8_WAIT_V(n) asm volatile("s_waitcnt vmcnt(" #n ")" ::: "memory")
#define PG8_WAIT_L(n) asm volatile("s_waitcnt lgkmcnt(" #n ")" ::: "memory")
#define PG8_BAR __builtin_amdgcn_s_barrier()
#define PG8_SCHED __builtin_amdgcn_sched_barrier(0)
    Unit cur, nxt; int ui = 0;
    if (!S.next(0, cur)) return;
    float zf; asm volatile("v_mov_b32 %0, 0" : "=v"(zf));
    f32x4 acc[2][2][4][2];
#pragma unroll
    for (int a = 0; a < 2; ++a)
#pragma unroll
        for (int b = 0; b < 2; ++b)
#pragma unroll
            for (int m = 0; m < 4; ++m)
#pragma unroll
                for (int n = 0; n < 2; ++n) acc[a][b][m][n] = (f32x4){zf, zf, zf, zf};
    bf16x8 At[4][2], B0[2][2], B1[2][2];
    const char* cA = (const char*)g.A + (size_t)cur.pm * tstep + cur.kb; const char* cB = (const char*)g.Bt + (size_t)cur.pn * tstep + cur.kb;
    PG8_STAGE(PG8_SB(0, 0), cB, voffB); PG8_STAGE(PG8_SB(0, 1), cB + hstep, voffB); PG8_STAGE(PG8_SA(0, 0), cA, voffA); PG8_STAGE(PG8_SA(0, 1), cA + hstep, voffA);
    if (wr == 1) PG8_BAR;
    PG8_WAIT_V(2); PG8_BAR;
    PG8_STAGE(PG8_SB(1, 0), cB + kstep, voffB); PG8_STAGE(PG8_SA(1, 0), cA + kstep, voffA); PG8_STAGE(PG8_SB(1, 1), cB + hstep + kstep, voffB);
    PG8_WAIT_V(6); PG8_BAR;
    for (;;) {
        const bool has_next = S.next(ui + 1, nxt);
        const char* nA = has_next ? (const char*)g.A + (size_t)nxt.pm * tstep + nxt.kb : cA; const char* nB = has_next ? (const char*)g.Bt + (size_t)nxt.pn * tstep + nxt.kb : cB;
        for (int t = 0; t < nt; t += 2) {
            const bool last = (t == nt - 2);
            const char* a1 = cA + (size_t)(t + 1) * kstep;
            const char* a2 = last ? nA : cA + (size_t)(t + 2) * kstep; const char* b2 = last ? nB : cB + (size_t)(t + 2) * kstep;
            const char* a3 = a2 + kstep; const char* b3 = b2 + kstep;
            PG8_LDB(B0, 0, 0); PG8_LDB(B1, 0, 1); PG8_SCHED; PG8_LDA(At, 0, 0); PG8_STAGE(PG8_SA(1, 1), a1 + hstep, voffA);
            PG8_WAIT_V(8); PG8_WAIT_L(0); PG8_BAR; PG8_MMA(0, 0, At, B0); PG8_MMA(0, 1, At, B1); PG8_BAR; PG8_SCHED;
            PG8_LDA(At, 0, 1); PG8_STAGE(PG8_SB(0, 0), b2, voffB); PG8_STAGE(PG8_SB(0, 1), b2 + hstep, voffB); PG8_STAGE(PG8_SA(0, 0), a2, voffA);
            PG8_WAIT_V(8); PG8_WAIT_L(0); PG8_BAR; PG8_MMA(1, 0, At, B0); PG8_MMA(1, 1, At, B1); PG8_BAR; PG8_SCHED;
            PG8_LDB(B0, 1, 0); PG8_LDB(B1, 1, 1); PG8_SCHED; PG8_LDA(At, 1, 0); PG8_STAGE(PG8_SA(0, 1), a2 + hstep, voffA);
            PG8_WAIT_V(8); PG8_WAIT_L(0); PG8_BAR; PG8_MMA(0, 0, At, B0); PG8_MMA(0, 1, At, B1); PG8_BAR; PG8_SCHED;
            PG8_LDA(At, 1, 1); PG8_STAGE(PG8_SB(1, 0), b3, voffB); PG8_STAGE(PG8_SB(1, 1), b3 + hstep, voffB); PG8_STAGE(PG8_SA(1, 0), a3, voffA);
            PG8_WAIT_V(8); PG8_WAIT_L(0); PG8_BAR; PG8_MMA(1, 0, At, B0); PG8_MMA(1, 1, At, B1); PG8_BAR; PG8_SCHED;
        }
        if (wr == 0) PG8_BAR;
        { int l_; asm volatile("v_mbcnt_lo_u32_b32 %0, -1, 0\n\tv_mbcnt_hi_u32_b32 %0, -1, %0" : "=v"(l_)); const int fr_ = l_ & 15, fq_ = l_ >> 4;
          Unit cu = cur; asm volatile("" : "+s"(cu.pm), "+s"(cu.pn), "+s"(cu.kb));
          E(acc, cu, wr, wc, fr_, fq_); }
        if (!has_next) break;
#pragma unroll
        for (int a = 0; a < 2; ++a)
#pragma unroll
            for (int b = 0; b < 2; ++b)
#pragma unroll
                for (int m = 0; m < 4; ++m)
#pragma unroll
                    for (int n = 0; n < 2; ++n) acc[a][b][m][n] = (f32x4){zf, zf, zf, zf};
        cur = nxt; cA = nA; cB = nB; ++ui;
        if (wr == 1) PG8_BAR;
    }
    PG8_WAIT_V(0);
    PG8_BAR;
#undef PG8_SA
#undef PG8_SB
#undef PG8_STAGE
#undef PG8_LDA
#undef PG8_LDB
#undef PG8_MMA
#undef PG8_WAIT_V
#undef PG8_WAIT_L
#undef PG8_BAR
#undef PG8_SCHED
}
}

constexpr int DM = 4096, SEQ = 4096, NB = 4, MP = NB * SEQ, SB = 16, SL = 16, MS = SB * SL, MT = MP + MS;
constexpr int MTP = MT + 128;
constexpr int NCK = MP / 64 + SB;
constexpr int PAST = 1024, LKS = PAST + SL, LKSP = 1088;
constexpr int DSSM = 2048, NH = 32, HDIM = 64, NG = 4, DST = 128, DCONV = 3072, GB = NG * DST;
constexpr int DDIFF = 1024, DMEM = 1024, NMEM = 256, NMROWS = NB * NMEM;
constexpr int DIN = 11296, N1P = 11520, NMKV = 2048, NW1 = N1P + NMKV;
constexpr int NCH = SEQ / 64;
constexpr float NORM_EPS = 1e-6f, SUBLN_EPS = 1e-5f;
constexpr int T_Z = 0, T_XBC = 8, T_QD = 20, T_KD = 24, T_VD = 28, T_GD = 32, T_QM = 36, T_GM = 40, T_DT = 44, T_MEM = 45;
constexpr int PM_S = 64, PM_MEM = 65;

constexpr size_t O_YP = 0, O_YS = O_YP + (size_t)MP * DM, O_PCONV = O_YS + (size_t)MS * DM, O_PSSM = O_PCONV + 2ull * NB * 3 * DCONV,
    O_PK = O_PSSM + 2ull * NB * NH * HDIM * DST, O_PV = O_PK + 2ull * MP * 1024, O_PMK = O_PV + 2ull * MP * 1024, O_PMV = O_PMK + 2ull * NMROWS * 1024,
    O_SCONV = O_PMV + 2ull * NMROWS * 1024, O_SSSM = O_SCONV + 2ull * SB * 3 * DCONV, O_SK = O_SSSM + 2ull * SB * NH * HDIM * DST, O_SV = O_SK + 2ull * MS * 1024,
    O_END = O_SV + 2ull * MS * 1024;
static_assert(O_END == 151363584ull, "output size");

constexpr size_t MiB = 1u << 20;
constexpr size_t al(size_t x) { return (x + 4095) & ~(size_t)4095; }
constexpr size_t WS_CTL = 0, CTL_ZERO_BYTES = 1 * MiB;
constexpr size_t WS_W1 = 1 * MiB;
constexpr size_t W1_LAYER = (size_t)NW1 * DM * 2;
constexpr size_t WS_WO = al(WS_W1 + 2 * W1_LAYER);
constexpr size_t WO_LAYER = (size_t)DM * DM * 2;
constexpr size_t WS_HALL = al(WS_WO + 2 * WO_LAYER);
constexpr size_t WS_Z = al(WS_HALL + (size_t)(MT + 2 * NMROWS) * DM * 2);
constexpr size_t WS_XBC = al(WS_Z + (size_t)MT * DSSM * 2);
constexpr size_t WS_QD = al(WS_XBC + (size_t)MT * DCONV * 2);
constexpr size_t WS_GD = al(WS_QD + (size_t)MT * 1024 * 2);
constexpr size_t WS_QM = al(WS_GD + (size_t)MT * 1024 * 2);
constexpr size_t WS_GM = al(WS_QM + (size_t)MT * 1024 * 2);
constexpr size_t WS_KD = al(WS_GM + (size_t)MT * 1024 * 2);
constexpr size_t WS_VD = al(WS_KD + (size_t)MP * 1024 * 2);
constexpr size_t WS_KS = al(WS_VD + (size_t)MP * 1024 * 2);
constexpr size_t WS_VS = al(WS_KS + (size_t)SB * LKSP * 1024 * 2);
constexpr size_t WS_MK = al(WS_VS + (size_t)SB * LKSP * 1024 * 2);
constexpr size_t WS_MV = al(WS_MK + (size_t)NMROWS * 1024 * 2);
constexpr size_t WS_MKS = al(WS_MV + (size_t)NMROWS * 1024 * 2);
constexpr size_t WS_MVS = al(WS_MKS + (size_t)SB * NMEM * 1024 * 2);
constexpr size_t WS_DT = al(WS_MVS + (size_t)SB * NMEM * 1024 * 2);
constexpr size_t WS_DC = al(WS_DT + (size_t)MTP * 32 * 4);
constexpr size_t WS_XT = al(WS_DC + (size_t)NB * NCH * NH * 4);
constexpr size_t WS_BT = al(WS_XT + (size_t)NCK * DSSM * 64 * 2);
constexpr size_t WS_BTOK = al(WS_BT + (size_t)NCK * GB * 64 * 2);
constexpr size_t WS_CTOK = al(WS_BTOK + (size_t)MTP * GB * 2);
constexpr size_t WS_ST = al(WS_CTOK + (size_t)MTP * GB * 2);
constexpr size_t WS_Y = al(WS_ST + (size_t)NB * NCH * NH * 8192 * 2);
constexpr size_t WS_O2P = WS_XBC;
static_assert(16ull * MS * DM * 4 <= (size_t)MT * DCONV * 2, "O2P fits inside XBC");
constexpr size_t WS_CHK = al(WS_Y + (size_t)MT * DM * 2);
constexpr size_t WS_X1 = al(WS_CHK + 1 * MiB);
constexpr size_t WS_XS1 = WS_CHK;
constexpr size_t WS_XS2 = al(WS_X1 + (size_t)MT * DM * 2);
constexpr size_t WS_RS1 = WS_XS2 + 1 * MiB;
constexpr size_t WS_END = WS_RS1 + 1 * MiB;
static_assert(WS_END <= 1480589312ull, "workspace map must fit 4 x the largest input");
constexpr int CW_TMO = 0, CW_CODE = 1;
constexpr int CW_BAR = 4096;
constexpr int CW_SB = 32768;
constexpr int CW_PBD = 34816;
constexpr int CW_Q = 36864;
constexpr int CW_XC = 16384;

constexpr int RING_OFF = 0, RING_BYTES = 155648;
constexpr int LDSCTL_OFF = RING_BYTES, MISC_OFF = LDSCTL_OFF + 320;
constexpr int LDS_BYTES = 159744;
static_assert(MISC_OFF + 128 <= LDS_BYTES, "LDS map");
constexpr int NWAVES = 8;

#define GAS __attribute__((address_space(1)))
#define LAS __attribute__((address_space(3)))
typedef unsigned short bf16;
typedef unsigned v4u __attribute__((ext_vector_type(4)));
typedef unsigned v2u __attribute__((ext_vector_type(2)));
typedef float f32x4 __attribute__((ext_vector_type(4)));
typedef float f32x16 __attribute__((ext_vector_type(16)));
typedef short bf16x8 __attribute__((ext_vector_type(8)));
typedef short s16x4 __attribute__((ext_vector_type(4)));
typedef GAS unsigned gu32;
#define RLX_AGENT __ATOMIC_RELAXED, __HIP_MEMORY_SCOPE_AGENT
#define LDS_WAIT() asm volatile("s_waitcnt lgkmcnt(0)" ::: "memory")
#define VM_WAIT() asm volatile("s_waitcnt vmcnt(0)" ::: "memory")
__device__ __forceinline__ unsigned f2bf(float f) { unsigned u = __builtin_bit_cast(unsigned, f); return (u + 0x7fffu + ((u >> 16) & 1u)) >> 16; }
typedef float f32x2_t __attribute__((ext_vector_type(2)));
typedef __bf16 bf16x2_t __attribute__((ext_vector_type(2)));
__device__ __forceinline__ unsigned pk2(float lo, float hi) { const f32x2_t v = {lo, hi}; const bf16x2_t b = __builtin_convertvector(v, bf16x2_t); return __builtin_bit_cast(unsigned, b); }
__device__ __forceinline__ float bflo(unsigned u) { return __builtin_bit_cast(float, u << 16); }
__device__ __forceinline__ float bfhi(unsigned u) { return __builtin_bit_cast(float, u & 0xffff0000u); }
__device__ __forceinline__ float bf2f(bf16 h) { return __builtin_bit_cast(float, (unsigned)h << 16); }
__device__ __forceinline__ float ex2(float x) { return __builtin_amdgcn_exp2f(x); }
__device__ __forceinline__ float fexp(float x) { return __builtin_amdgcn_exp2f(x * 1.4426950408889634f); }
__device__ __forceinline__ float silu(float x) { return x * __builtin_amdgcn_rcpf(1.f + fexp(-x)); }
__device__ __forceinline__ float softplus(float x) { return x > 20.f ? x : log1pf(__expf(x)); }
__device__ __forceinline__ float shx(float v, int lane, int m) { return __builtin_bit_cast(float, __builtin_amdgcn_ds_bpermute((lane ^ m) << 2, __builtin_bit_cast(int, v))); }
__device__ __forceinline__ float shl_from(float v, int src_lane) { return __builtin_bit_cast(float, __builtin_amdgcn_ds_bpermute(src_lane << 2, __builtin_bit_cast(int, v))); }
__device__ __forceinline__ float wave_sum(float v, int lane) {
#pragma unroll
    for (int o = 1; o < 64; o <<= 1) v += shx(v, lane, o);
    return v;
}

#define XB_TMO      128
#define XB_XCNT(j)  (256  + 64 * (j))
#define XB_XSUB(j)  (1280 + 64 * (j))
#define XB_XGEN(j)  (2304 + 64 * (j))
#define XB_TOP      3328
#define XB_TOPGEN   3392
#define XCD_BAR_WORDS 3456
#define XB_SPIN_CAP (1u << 18)
__device__ __forceinline__ unsigned xb_ld(unsigned* p)              { return __hip_atomic_load(p, __ATOMIC_RELAXED, __HIP_MEMORY_SCOPE_AGENT); }
__device__ __forceinline__ unsigned xb_add(unsigned* p, unsigned v) { return __hip_atomic_fetch_add(p, v, __ATOMIC_RELAXED, __HIP_MEMORY_SCOPE_AGENT); }
__device__ __forceinline__ unsigned xb_xcc_id() { return (unsigned)__builtin_amdgcn_s_getreg((3 << 11) | 20) & 0xFu; }
#define XB_SPIN(cond, bar) do { unsigned _sp = 0; while (cond) { __builtin_amdgcn_s_sleep(1); \
    if ((++_sp & 255u) == 0u) { if (xb_ld(&(bar)[XB_TMO])) break; if (_sp > XB_SPIN_CAP) { atomicAdd(&(bar)[XB_TMO], 1u); break; } } } } while (0)
struct XcdBarrier { unsigned* bar; unsigned x; volatile LAS unsigned* st; };
__device__ __forceinline__ XcdBarrier xcd_barrier_post(unsigned* bar, volatile LAS unsigned* st) {
    XcdBarrier b; b.bar = bar; b.x = xb_xcc_id(); b.st = st;
    if (threadIdx.x == 0) (void)xb_add(&bar[XB_XCNT(b.x)], 1u);
    return b;
}
__device__ __forceinline__ void xcd_barrier_complete(unsigned* bar, unsigned x, unsigned& nloc, unsigned& nx) {
    const unsigned G = gridDim.x * gridDim.y * gridDim.z;
    unsigned sum, cnt, mine, sp = 0u;
    for (;;) {
        sum = 0u; cnt = 0u; mine = 0u;
#pragma unroll
        for (unsigned j = 0; j < 16; ++j) { const unsigned c = xb_ld(&bar[XB_XCNT(j)]); sum += c; cnt += (c > 0u) ? 1u : 0u; mine = (j == x) ? c : mine; }
        if (sum == G) break;
        __builtin_amdgcn_s_sleep(1);
        if ((++sp & 255u) == 0u) { if (xb_ld(&bar[XB_TMO])) break; if (sp > XB_SPIN_CAP) { atomicAdd(&bar[XB_TMO], 1u); break; } }
    }
    nloc = mine > 0u ? mine : 1u; nx = cnt > 0u ? cnt : 1u;
}
__device__ __forceinline__ void xcd_barrier(const XcdBarrier& b, const bool leader  ) {
    asm volatile("s_waitcnt vmcnt(0)" ::: "memory");
    __syncthreads();
    if (leader) {
        unsigned* bar = b.bar;
        __builtin_amdgcn_s_waitcnt(0);
        unsigned nloc = b.st[0], nx = b.st[1];
        if (nloc == 0u) { xcd_barrier_complete(bar, b.x, nloc, nx); b.st[0] = nloc; b.st[1] = nx; }
        const unsigned old = xb_add(&bar[XB_XSUB(b.x)], 1u);
        const unsigned gen = old / nloc;
        if (old + 1u == (gen + 1u) * nloc) {
            __builtin_amdgcn_fence(__ATOMIC_RELEASE, "agent");
            asm volatile("s_waitcnt vmcnt(0)" ::: "memory");
            const unsigned og = xb_add(&bar[XB_TOP], 1u);
            const unsigned tg = og / nx;
            if (og + 1u == (tg + 1u) * nx) xb_add(&bar[XB_TOPGEN], 1u);
            else XB_SPIN(xb_ld(&bar[XB_TOPGEN]) == tg, bar);
            __builtin_amdgcn_fence(__ATOMIC_ACQUIRE, "agent");
            xb_add(&bar[XB_XGEN(b.x)], 1u);
            asm volatile("s_waitcnt vmcnt(0)" ::: "memory");
        } else {
            XB_SPIN(xb_ld(&bar[XB_XGEN(b.x)]) == gen, bar);
            __builtin_amdgcn_fence(__ATOMIC_ACQUIRE, "agent");
            asm volatile("s_waitcnt vmcnt(0)" ::: "memory");
        }
    }
    __syncthreads();
}

__device__ __forceinline__ void sub_barrier(unsigned* cnt, unsigned n, const bool leader) {
    asm volatile("s_waitcnt vmcnt(0)" ::: "memory");
    __syncthreads();
    if (leader) {
        __builtin_amdgcn_fence(__ATOMIC_RELEASE, "agent");
        asm volatile("s_waitcnt vmcnt(0)" ::: "memory");
        (void)xb_add(cnt, 1u);
        unsigned sp = 0u;
        while (xb_ld(cnt) < n) { __builtin_amdgcn_s_sleep(2); if (++sp > (1u << 24)) break; }
        __builtin_amdgcn_fence(__ATOMIC_ACQUIRE, "agent");
        asm volatile("s_waitcnt vmcnt(0)" ::: "memory");
    }
    __syncthreads();
}

struct Frame {
    LAS unsigned char* lds;
    volatile LAS unsigned* MISC;
    GAS unsigned char* ws; GAS float* out;
    int tid, lane, wave, G, bx;
};
__device__ __forceinline__ float zero_asm() { float z; asm volatile("v_mov_b32 %0, 0" : "=v"(z)); return z; }
__device__ __forceinline__ int lane_id_asm() { int l; asm volatile("v_mbcnt_lo_u32_b32 %0, -1, 0\n\tv_mbcnt_hi_u32_b32 %0, -1, %0" : "=v"(l)); return l; }
#define WSB(off) ((bf16*)(GAS bf16*)(F.ws + (off)))
#define WSF(off) ((float*)(GAS float*)(F.ws + (off)))
constexpr int INP_OFF = LDSCTL_OFF;
__device__ __forceinline__ const float* inp_ptr(const Frame& F, int i) {
    const volatile LAS unsigned* p = (const volatile LAS unsigned*)(F.lds + INP_OFF) + 2 * i;
    const unsigned lo = __builtin_amdgcn_readfirstlane(p[0]), hi = __builtin_amdgcn_readfirstlane(p[1]);
    return (const float*)(const GAS float*)(((unsigned long long)hi << 32) | lo);
}
#define INP(i) inp_ptr(F, (i))

__device__ __forceinline__ void p0_transpose_item(const float* W, int K, int N, bf16* WT, int dst_row0, LAS float* scr, int k0, int n0, int lane, const float* ksc = nullptr  ) {
    float wv[32]; const GAS float* wp = (const GAS float*)W + (size_t)(k0 + (lane >> 5)) * N + n0 + (lane & 31);
#pragma unroll
    for (int i = 0; i < 32; ++i) wv[i] = wp[(size_t)(2 * i) * N];
#pragma unroll
    for (int i = 0; i < 32; ++i) scr[(2 * i + (lane >> 5)) * 33 + (lane & 31)] = wv[i];
    LDS_WAIT(); asm volatile("" ::: "memory");
    const int c = lane & 7;
    f32x4 k0v = {1.f, 1.f, 1.f, 1.f}, k1v = k0v; if (ksc) { k0v = *(const GAS f32x4*)(ksc + k0 + 8 * c); k1v = *(const GAS f32x4*)(ksc + k0 + 8 * c + 4); }
#pragma unroll
    for (int j = 0; j < 4; ++j) { const int n = (lane >> 3) + 8 * j; const LAS float* s = scr + (8 * c) * 33 + n;
        v4u o; o.x = pk2(s[0 * 33] * k0v[0], s[1 * 33] * k0v[1]); o.y = pk2(s[2 * 33] * k0v[2], s[3 * 33] * k0v[3]); o.z = pk2(s[4 * 33] * k1v[0], s[5 * 33] * k1v[1]); o.w = pk2(s[6 * 33] * k1v[2], s[7 * 33] * k1v[3]);
        *(GAS v4u*)(WT + (size_t)(dst_row0 + n) * K + k0 + 8 * c) = o; }
    LDS_WAIT(); asm volatile("" ::: "memory");
}
__device__ __forceinline__ void rms_row_to_bf16(const float* xrow, const float* w, bf16* orow, int lane) {
    const GAS f32x4* xr = (const GAS f32x4*)xrow + lane;
    f32x4 v[16]; float s = 0.f;
#pragma unroll
    for (int j = 0; j < 16; ++j) { v[j] = xr[64 * j]; s += (v[j].x * v[j].x + v[j].y * v[j].y) + (v[j].z * v[j].z + v[j].w * v[j].w); }
    const float rstd = 1.f / sqrtf(wave_sum(s, lane) * (1.f / DM) + NORM_EPS);
    const GAS f32x4* wr = (const GAS f32x4*)w + lane; GAS v2u* o = (GAS v2u*)orow + lane;
#pragma unroll
    for (int j = 0; j < 16; ++j) { const f32x4 ww = wr[64 * j]; v2u q; q.x = pk2(v[j].x * rstd * ww.x, v[j].y * rstd * ww.y); q.y = pk2(v[j].z * rstd * ww.z, v[j].w * rstd * ww.w); o[64 * j] = q; }
}
__device__ __forceinline__ void p0_prologue(Frame& F) {
    LAS float* scr = (LAS float*)(F.lds + RING_OFF + F.wave * 16384);
    const int gw = F.bx * NWAVES + F.wave, NGW = F.G * NWAVES;
    const float* w_in = INP(11); const float* w_mem_kv = INP(24); const float* w_out = INP(25);
    constexpr int NB1 = DIN / 32  , I_IN = 64 * NB1, I_MK = 64 * (NMKV / 32), I_WO = 64 * (DM / 32);
    constexpr int NITEMS = 2 * (I_IN + I_MK + I_WO);
#pragma unroll 1
    for (int it = gw; it < NITEMS; it += NGW) {
        int r = it; const int l = r / (I_IN + I_MK + I_WO); r -= l * (I_IN + I_MK + I_WO);
        bf16* W1l = WSB(WS_W1) + (size_t)l * NW1 * DM;
        if (r < I_IN) { const int kb = r / NB1, nb = r % NB1; const int db = nb < 160 ? nb : (nb == 160 ? 352 : nb - 1);
            p0_transpose_item(w_in + (size_t)l * DM * DIN, DM, DIN, W1l, db * 32, scr, kb * 64, nb * 32, F.lane, l == 1 ? INP(9  ) + DM : nullptr); continue; }
        r -= I_IN;
        if (r < I_MK) { const int kb = r / (NMKV / 32), nb = r % (NMKV / 32);
            p0_transpose_item(w_mem_kv + (size_t)l * DM * NMKV, DM, NMKV, W1l, N1P + nb * 32, scr, kb * 64, nb * 32, F.lane); continue; }
        r -= I_MK;
        { const int kb = r / (DM / 32), nb = r % (DM / 32);
            p0_transpose_item(w_out + (size_t)l * DM * DM, DM, DM, WSB(WS_WO) + (size_t)l * DM * DM, nb * 32, scr, kb * 64, nb * 32, F.lane); }
    }
#pragma unroll 1
    for (int it = gw; it < 2 * (N1P - 11296); it += NGW) { const int l = it / (N1P - 11296), rr = 11296 + it % (N1P - 11296);
        GAS v4u* o = (GAS v4u*)(WSB(WS_W1) + (size_t)l * NW1 * DM + (size_t)rr * DM) + F.lane;
        unsigned zz = 0u; asm volatile("" : "+v"(zz));
#pragma unroll
        for (int j = 0; j < 8; ++j) o[64 * j] = (v4u){zz, zz, zz, zz}; }
    const float* x_prompt = INP(0); const float* x_sample = INP(1); const float* mem_prompt = INP(2); const float* norm_pre_w = INP(9); const float* mem_norm_w = INP(23);
#pragma unroll 1
    for (int m = gw; m < MT + 2 * NMROWS; m += NGW) {
        if (m < MP) rms_row_to_bf16(x_prompt + (size_t)m * DM, norm_pre_w, WSB(WS_HALL) + (size_t)m * DM, F.lane);
        else if (m < MT) rms_row_to_bf16(x_sample + (size_t)(m - MP) * DM, norm_pre_w, WSB(WS_HALL) + (size_t)m * DM, F.lane);
        else { const int q = m - MT, l = q / NMROWS, r = q % NMROWS; rms_row_to_bf16(mem_prompt + (size_t)r * DM, mem_norm_w + l * DM, WSB(WS_HALL) + (size_t)m * DM, F.lane); }
    }
}

struct Sched1 {
    int G, c, mem_pm0;
    __device__ __forceinline__ bool next(int i, pg8::Unit& u) const {
        long L = (long)i * G + c; constexpr int NR = 65 * 45; u.kb = 0;
        if (L < NR) { pg8::rect_tile((int)L, 65, 45, u.pm, u.pn); return true; }
        L -= NR; if (L < 32) { u.pm = mem_pm0 + (int)(L & 3); u.pn = T_MEM + (int)(L >> 2); return true; }
        return false;
    }
};
struct Sched2 {
    int G, c;
    __device__ __forceinline__ bool next(int i, pg8::Unit& u) const {
        const long L = (long)i * G + c; u.kb = 0; if (L >= 64 * 16) return false; pg8::rect_tile((int)L, 64, 16, u.pm, u.pn); return true; }
};
struct Sched2S {
    int G, c;
    __device__ __forceinline__ bool next(int i, pg8::Unit& u) const {
        const long L = (long)i * G + c; if (L >= 256) return false; u.pm = PM_S; u.pn = (int)(L >> 4); u.kb = (int)(L & 15) * 256 * 2; return true; }
};

__device__ __forceinline__ void st_bf8(bf16* p, const f32x4& v0, const f32x4& v1) {
    v4u w; w.x = pk2(v0[0], v0[1]); w.y = pk2(v0[2], v0[3]); w.z = pk2(v1[0], v1[1]); w.w = pk2(v1[2], v1[3]); *(GAS v4u*)p = w; }
__device__ __forceinline__ void st_f8(float* p, const f32x4& v0, const f32x4& v1) { *(GAS f32x4*)p = v0; *(GAS f32x4*)(p + 4) = v1; }

struct Epi1 {
    static constexpr bool PERM = true;
    unsigned char* ws; float* out; const float* dt_bias; int layer, mem_pm0;
    __device__ __forceinline__ void operator()(const f32x4 (&acc)[2][2][4][2], const pg8::Unit& u, int wr, int wc, int fr, int fq) const {
        const int pn = u.pn, pm = u.pm, cl = wc * 32 + 8 * fq, rl = wr * 64 + fr;
#define EB(off) ((bf16*)(ws + (off)))
        float* const DT = (float*)(ws + WS_DT); const float* const RS1 = (const float*)(ws + WS_RS1);
        float* const o_pk = out + O_PK + (size_t)layer * MP * 1024; float* const o_pv = out + O_PV + (size_t)layer * MP * 1024;
        float* const o_sk = out + O_SK + (size_t)layer * MS * 1024; float* const o_sv = out + O_SV + (size_t)layer * MS * 1024;
        float* const o_pconv = out + O_PCONV + (size_t)layer * NB * 3 * DCONV; float* const o_sconv = out + O_SCONV + (size_t)layer * SB * 3 * DCONV;
        float* const o_pmk = out + O_PMK + (size_t)layer * NMROWS * 1024; float* const o_pmv = out + O_PMV + (size_t)layer * NMROWS * 1024;
        if (pn == T_DT) {
            if (wc == 0) {
                const f32x4 b0 = *(const GAS f32x4*)(dt_bias + 8 * fq), b1 = *(const GAS f32x4*)(dt_bias + 8 * fq + 4);
#pragma unroll
                for (int ai = 0; ai < 2; ++ai)
#pragma unroll
                    for (int m = 0; m < 4; ++m) { const size_t row = (size_t)pm * 256 + ai * 128 + m * 16 + rl; const float rs = layer == 1 ? RS1[row] : 1.f; f32x4 v0 = acc[ai][0][m][0] * rs + b0, v1 = acc[ai][0][m][1] * rs + b1;
#pragma unroll
                        for (int e = 0; e < 4; ++e) { v0[e] = softplus(v0[e]); v1[e] = softplus(v1[e]); }
                        st_f8(DT + row * 32 + 8 * fq, v0, v1); __builtin_amdgcn_sched_barrier(0); }
            }
            return;
        }
        bf16* bb; float* ff = nullptr; int bld = 1024, mode = 0, rowbase = pm * 256, ct;
        if (pn >= T_MEM) { ct = (pn - T_MEM) & 3; const bool isK = (pn - T_MEM) < 4; bb = isK ? EB(WS_MK) : EB(WS_MV); ff = isK ? o_pmk : o_pmv; rowbase = (pm - mem_pm0) * 256; }
        else if (pn >= T_GM) { bb = EB(WS_GM); ct = pn - T_GM; }
        else if (pn >= T_QM) { bb = EB(WS_QM); ct = pn - T_QM; }
        else if (pn >= T_GD) { bb = EB(WS_GD); ct = pn - T_GD; }
        else if (pn >= T_KD) { const bool isK = pn < T_VD; ct = pn - (isK ? T_KD : T_VD);
            if (pm < PM_S) { bb = isK ? EB(WS_KD) : EB(WS_VD); ff = isK ? o_pk : o_pv; } else { bb = isK ? EB(WS_KS) : EB(WS_VS); ff = isK ? o_sk : o_sv; mode = 1; } }
        else if (pn >= T_QD) { bb = EB(WS_QD); ct = pn - T_QD; }
        else if (pn >= T_XBC) { bb = EB(WS_XBC); bld = DCONV; ct = pn - T_XBC; mode = 2; }
        else { bb = EB(WS_Z); bld = DSSM; ct = pn; }
        const int col = ct * 256 + cl;
#pragma unroll
        for (int ai = 0; ai < 2; ++ai)
#pragma unroll
            for (int m = 0; m < 4; ++m) {
                const int r = ai * 128 + m * 16 + rl; size_t bo, fo = 0; bool fok = ff != nullptr; float* fp = ff;
                if (mode == 1) { bo = ((size_t)(r >> 4) * LKSP + PAST + (r & 15)) * 1024 + col; fo = (size_t)r * 1024 + col; }
                else { bo = (size_t)(rowbase + r) * bld + col; fo = (size_t)(rowbase + r) * 1024 + col; }
                if (mode == 2) { const int row = rowbase + r; fok = false;
                    if (pm < PM_S) { const int t = row & (SEQ - 1); if (t >= SEQ - 3) { fok = true; fp = o_pconv; fo = (size_t)((row >> 12) * 3 + (t - (SEQ - 3))) * DCONV + col; } }
                    else { const int sr = row - MP, i = sr & 15; if (i >= SL - 3) { fok = true; fp = o_sconv; fo = (size_t)((sr >> 4) * 3 + (i - (SL - 3))) * DCONV + col; } } }
                const float rs = (layer == 1 && pm <= PM_S) ? RS1[pm * 256 + r] : 1.f;
#pragma unroll
                for (int bj = 0; bj < 2; ++bj) { const f32x4 v0 = acc[ai][bj][m][0] * rs, v1 = acc[ai][bj][m][1] * rs; st_bf8(bb + bo + bj * 128, v0, v1); if (fok) st_f8(fp + fo + bj * 128, v0, v1); }
                __builtin_amdgcn_sched_barrier(0);
            }
#undef EB
    }
};
struct Epi2 {
    static constexpr bool PERM = true; bf16* O;
    __device__ __forceinline__ void operator()(const f32x4 (&acc)[2][2][4][2], const pg8::Unit& u, int wr, int wc, int fr, int fq) const {
        const int cl = wc * 32 + 8 * fq, rl = wr * 64 + fr;
#pragma unroll
        for (int ai = 0; ai < 2; ++ai)
#pragma unroll
            for (int m = 0; m < 4; ++m) { const size_t row = (size_t)u.pm * 256 + ai * 128 + m * 16 + rl;
#pragma unroll
                for (int bj = 0; bj < 2; ++bj) st_bf8(O + row * DM + u.pn * 256 + bj * 128 + cl, acc[ai][bj][m][0], acc[ai][bj][m][1]); __builtin_amdgcn_sched_barrier(0); }
    }
};
struct Sched2F {
    int G, c;
    __device__ __forceinline__ bool next(int i, pg8::Unit& u) const {
        if (i >= 4) return false; const int x = c & 7, j = c >> 3; u.kb = 0; u.pm = 16 * (x >> 1) + 4 * i + (j & 3); u.pn = 8 * (x & 1) + (j >> 2); return true; }
};
template <int LAYER>
struct Epi2F {
    static constexpr bool PERM = true;
    unsigned char* ws; float* out; const float* wpost; const float* xres; LAS unsigned char* xl;
    __device__ __forceinline__ void ldres(v4u (&d)[2][2], size_t go) const {
#pragma unroll
        for (int bj = 0; bj < 2; ++bj) {
            if (LAYER == 0) { d[bj][0] = *(const GAS v4u*)(xres + go + bj * 128); d[bj][1] = *(const GAS v4u*)(xres + go + bj * 128 + 4); }
            else d[bj][0] = *(const GAS v4u*)((const bf16*)xres + go + bj * 128); }
    }
    __device__ __forceinline__ void operator()(const f32x4 (&acc)[2][2][4][2], const pg8::Unit& u, int wr, int wc, int fr, int fq) const {
        const int lane = fq * 16 + fr, wid = wr * 4 + wc, pm = u.pm, pn = u.pn;
        LAS float* P = (LAS float*)xl; LAS float* S = (LAS float*)(xl + 4096);
        unsigned* cnt = (unsigned*)(ws + WS_CTL) + CW_XC + (LAYER * 64 + pm) * 64;
        float* slots = (float*)(ws + WS_XS1) + (size_t)pm * 256 * 16;
        const int cl = wc * 32 + 8 * fq, rl = wr * 64 + fr, gc = pn * 256 + cl;
        f32x4 wv[2][2];
#pragma unroll
        for (int bj = 0; bj < 2; ++bj) { wv[bj][0] = *(const GAS f32x4*)(wpost + gc + bj * 128); wv[bj][1] = *(const GAS f32x4*)(wpost + gc + bj * 128 + 4); }
        v4u pre[4][2][2];
#pragma unroll
        for (int m = 0; m < 4; ++m) ldres(pre[m], (size_t)(pm * 256 + m * 16 + rl) * DM + gc);
#pragma unroll
        for (int ai = 0; ai < 2; ++ai)
#pragma unroll
            for (int m = 0; m < 4; ++m) { float s = 0.f;
#pragma unroll
                for (int bj = 0; bj < 2; ++bj)
#pragma unroll
                    for (int n = 0; n < 2; ++n) { const f32x4 x = acc[ai][bj][m][n]; s += (x[0] * x[0] + x[1] * x[1]) + (x[2] * x[2] + x[3] * x[3]); }
                s += shx(s, lane, 16); s += shx(s, lane, 32);
                if (fq == 0) P[(ai * 128 + m * 16 + rl) * 4 + wc] = s; }
        LDS_WAIT(); __builtin_amdgcn_s_barrier(); asm volatile("" ::: "memory");
        const int row = wid * 32 + (lane & 31);
        if (lane < 32) { const f32x4 p = *(const LAS f32x4*)(P + row * 4); __hip_atomic_store(slots + row * 16 + pn, (p[0] + p[1]) + (p[2] + p[3]), __ATOMIC_RELAXED, __HIP_MEMORY_SCOPE_AGENT); }
        asm volatile("s_waitcnt vmcnt(0)" ::: "memory");
        if (lane == 0) (void)__hip_atomic_fetch_add(cnt, 1u, __ATOMIC_RELAXED, __HIP_MEMORY_SCOPE_AGENT);
        if (wid == 0) { unsigned sp = 0u;
            while ((unsigned)__builtin_amdgcn_readfirstlane(__hip_atomic_load(cnt, __ATOMIC_RELAXED, __HIP_MEMORY_SCOPE_AGENT)) < 128u) { __builtin_amdgcn_s_sleep(2); if (++sp > (1u << 22)) break; }
            __builtin_amdgcn_fence(__ATOMIC_ACQUIRE, "agent"); }
        asm volatile("s_waitcnt vmcnt(0) lgkmcnt(0)" ::: "memory"); __builtin_amdgcn_s_barrier(); asm volatile("" ::: "memory");
        if (lane < 32) { const unsigned long long* sl = (const unsigned long long*)(slots + row * 16); float t = 0.f;
#pragma unroll
            for (int k = 0; k < 8; ++k) { const unsigned long long w = __hip_atomic_load(sl + k, __ATOMIC_RELAXED, __HIP_MEMORY_SCOPE_AGENT); t += __uint_as_float((unsigned)w) + __uint_as_float((unsigned)(w >> 32)); }
            S[row] = 1.f / sqrtf(t * (1.f / DM) + NORM_EPS); }
        LDS_WAIT(); __builtin_amdgcn_s_barrier(); asm volatile("" ::: "memory");
#pragma unroll
        for (int ai = 0; ai < 2; ++ai) {
            if (ai == 1) {
#pragma unroll
                for (int m = 0; m < 4; ++m) ldres(pre[m], (size_t)(pm * 256 + 128 + m * 16 + rl) * DM + gc); }
#pragma unroll
            for (int m = 0; m < 4; ++m) { const int r = ai * 128 + m * 16 + rl; const float rs = S[r]; const size_t go = (size_t)(pm * 256 + r) * DM + gc; float s2 = 0.f;
#pragma unroll
                for (int bj = 0; bj < 2; ++bj) { f32x4 x0, x1;
                    if (LAYER == 0) { x0 = __builtin_bit_cast(f32x4, pre[m][bj][0]); x1 = __builtin_bit_cast(f32x4, pre[m][bj][1]); }
                    else { const v4u q = pre[m][bj][0]; x0 = (f32x4){bflo(q.x), bfhi(q.x), bflo(q.y), bfhi(q.y)}; x1 = (f32x4){bflo(q.z), bfhi(q.z), bflo(q.w), bfhi(q.w)}; }
                    const f32x4 y0 = x0 + acc[ai][bj][m][0] * rs * wv[bj][0], y1 = x1 + acc[ai][bj][m][1] * rs * wv[bj][1];
                    if (LAYER == 1) st_f8(out + go + bj * 128, y0, y1);
                    else { st_bf8((bf16*)(ws + WS_HALL) + go + bj * 128, y0, y1);
                        s2 += ((y0[0] * y0[0] + y0[1] * y0[1]) + (y0[2] * y0[2] + y0[3] * y0[3])) + ((y1[0] * y1[0] + y1[1] * y1[1]) + (y1[2] * y1[2] + y1[3] * y1[3])); } }
                if (LAYER == 0) { s2 += shx(s2, lane, 16); s2 += shx(s2, lane, 32); if (fq == 0) P[r * 4 + wc] = s2; }
                __builtin_amdgcn_sched_barrier(0); }
        }
        if (LAYER == 0) {
            LDS_WAIT(); __builtin_amdgcn_s_barrier(); asm volatile("" ::: "memory");
            if (lane < 32) { const f32x4 p = *(const LAS f32x4*)(P + row * 4); ((float*)(ws + WS_XS2))[(size_t)(pm * 256 + row) * 16 + pn] = (p[0] + p[1]) + (p[2] + p[3]); }
        }
    }
};
struct Epi2S {
    static constexpr bool PERM = true; float* O;
    __device__ __forceinline__ void operator()(const f32x4 (&acc)[2][2][4][2], const pg8::Unit& u, int wr, int wc, int fr, int fq) const {
        const int cl = wc * 32 + 8 * fq, rl = wr * 64 + fr; float* base = O + (size_t)(u.kb >> 9) * MS * DM + u.pn * 256 + cl;
#pragma unroll
        for (int ai = 0; ai < 2; ++ai)
#pragma unroll
            for (int m = 0; m < 4; ++m) { const size_t row = (size_t)ai * 128 + m * 16 + rl;
#pragma unroll
                for (int bj = 0; bj < 2; ++bj) st_f8(base + row * DM + bj * 128, acc[ai][bj][m][0], acc[ai][bj][m][1]);
                __builtin_amdgcn_sched_barrier(0); }
    }
};

__device__ __forceinline__ v4u pack8(const float (&o)[8]) { v4u w; w.x = pk2(o[0], o[1]); w.y = pk2(o[2], o[3]); w.z = pk2(o[4], o[5]); w.w = pk2(o[6], o[7]); return w; }
__device__ __forceinline__ void cvt8(const float* src, bf16* dst) {
    const f32x4 a = *(const GAS f32x4*)src, b = *(const GAS f32x4*)(src + 4); v4u w; w.x = pk2(a.x, a.y); w.y = pk2(a.z, a.w); w.z = pk2(b.x, b.y); w.w = pk2(b.z, b.w); *(GAS v4u*)dst = w; }
template <int LEN>
__device__ __forceinline__ void conv_item(const Frame& F, const bf16* XBC, int row0, int ck, int cb, float2 h0, float2 h1, float2 h2, const float* conv_w, const float* conv_b) {
    const int c = cb * 128 + 2 * F.lane;
    const f32x2_t w0 = *(const GAS f32x2_t*)(conv_w + c), w1 = *(const GAS f32x2_t*)(conv_w + DCONV + c), w2 = *(const GAS f32x2_t*)(conv_w + 2 * DCONV + c), w3 = *(const GAS f32x2_t*)(conv_w + 3 * DCONV + c);
    const f32x2_t bias = *(const GAS f32x2_t*)(conv_b + c);
    unsigned xin[LEN];
    const GAS unsigned* xp = (const GAS unsigned*)(XBC + (size_t)row0 * DCONV + c);
#pragma unroll
    for (int t = 0; t < LEN; ++t) xin[t] = xp[(size_t)t * (DCONV / 2)];
    float a0 = h0.x, a1 = h1.x, a2 = h2.x, b0 = h0.y, b1 = h1.y, b2 = h2.y;
#pragma unroll
    for (int t8 = 0; t8 < LEN; t8 += 8) {
        float oa[8], ob[8];
#pragma unroll
        for (int j = 0; j < 8; ++j) { const float xa = bflo(xin[t8 + j]), xb = bfhi(xin[t8 + j]);
            oa[j] = silu(bias.x + w0.x * a0 + w1.x * a1 + w2.x * a2 + w3.x * xa); ob[j] = silu(bias.y + w0.y * b0 + w1.y * b1 + w2.y * b2 + w3.y * xb);
            a0 = a1; a1 = a2; a2 = xa; b0 = b1; b1 = b2; b2 = xb; }
        if (LEN == 64 && cb < 20) { LAS unsigned char* tp = F.lds + F.wave * 18432 + (2 * F.lane) * 144 + t8 * 2; *(LAS v4u*)tp = pack8(oa); *(LAS v4u*)(tp + 144) = pack8(ob); }
        else if (cb < 16) { bf16* xt = WSB(WS_XT) + ((size_t)ck * DSSM + c) * 64 + t8; *(GAS v4u*)xt = pack8(oa); *(GAS v4u*)(xt + 64) = pack8(ob); }
        if (cb >= 16 && cb < 20) { const int n = c - DSSM; if (LEN != 64) { bf16* bt = WSB(WS_BT) + ((size_t)ck * GB + n) * 64 + t8; *(GAS v4u*)bt = pack8(oa); *(GAS v4u*)(bt + 64) = pack8(ob); }
            GAS unsigned* bk = (GAS unsigned*)(WSB(WS_BTOK) + (size_t)(row0 + t8) * GB + n);
#pragma unroll
            for (int j = 0; j < 8; ++j) bk[(size_t)j * (GB / 2)] = pk2(oa[j], ob[j]); }
        else if (cb >= 20) { const int n = c - DSSM - GB; GAS unsigned* ckp = (GAS unsigned*)(WSB(WS_CTOK) + (size_t)(row0 + t8) * GB + n);
#pragma unroll
            for (int j = 0; j < 8; ++j) ckp[(size_t)j * (GB / 2)] = pk2(oa[j], ob[j]); }
    }
    if (LEN == 64 && cb < 20) {
        LDS_WAIT(); asm volatile("" ::: "memory");
        const LAS unsigned char* tr = F.lds + F.wave * 18432 + (F.lane >> 3) * 144 + (F.lane & 7) * 16;
        bf16* dst = (cb < 16 ? WSB(WS_XT) + ((size_t)ck * DSSM + cb * 128) * 64 : WSB(WS_BT) + ((size_t)ck * GB + (cb - 16) * 128) * 64) + (F.lane >> 3) * 64 + (F.lane & 7) * 8;
#pragma unroll
        for (int it = 0; it < 16; ++it) *(GAS v4u*)(dst + (8 * it) * 64) = *(const LAS v4u*)(tr + (8 * it) * 144);
        LDS_WAIT(); asm volatile("" ::: "memory");
    }
}
__device__ __forceinline__ void conv_phase(Frame& F, int layer) {
    const int gw = F.bx * NWAVES + F.wave, NGW = F.G * NWAVES, lane = F.lane;
    constexpr int NCB = DCONV / 128, NPI = (MP / 64) * NCB, NSI = SB * NCB;
    const float* cache_conv = INP(3); const float* conv_w = INP(12) + (size_t)layer * 4 * DCONV; const float* conv_b = INP(13) + layer * DCONV;
    const bf16* XBC = WSB(WS_XBC);
#pragma unroll 1
    for (int it = gw; it < NPI + NSI; it += NGW) {
        if (it < NPI) { const int ck = it / NCB, cb = it % NCB, row0 = ck * 64, c = cb * 128 + 2 * lane;
            float2 h0 = {0.f, 0.f}, h1 = {0.f, 0.f}, h2 = {0.f, 0.f};
            if ((ck & (NCH - 1)) != 0) { const GAS unsigned* hp = (const GAS unsigned*)(XBC + (size_t)(row0 - 3) * DCONV + c); const unsigned u0 = hp[0], u1 = hp[DCONV / 2], u2 = hp[DCONV];
                h0 = {bflo(u0), bfhi(u0)}; h1 = {bflo(u1), bfhi(u1)}; h2 = {bflo(u2), bfhi(u2)}; }
            conv_item<64>(F, XBC, row0, ck, cb, h0, h1, h2, conv_w, conv_b); }
        else { const int v = it - NPI, b = v / NCB, cb = v % NCB, row0 = MP + b * SL, c = cb * 128 + 2 * lane;
            const float* cc = cache_conv + (size_t)((layer * SB + b) * 3) * DCONV + c;
            const f32x2_t q0 = *(const GAS f32x2_t*)cc, q1 = *(const GAS f32x2_t*)(cc + DCONV), q2 = *(const GAS f32x2_t*)(cc + 2 * DCONV);
            conv_item<SL>(F, XBC, row0, MP / 64 + b, cb, float2{q0.x, q0.y}, float2{q1.x, q1.y}, float2{q2.x, q2.y}, conv_w, conv_b); }
    }
}
__device__ __forceinline__ void cache_convert(Frame& F, int layer, int rank, int nranks) {
    const size_t gt = (size_t)rank * (NWAVES * 64) + F.tid, NT = (size_t)nranks * (NWAVES * 64);
    { const float* sk = INP(5  ) + (size_t)layer * SB * PAST * 1024; const float* sv = INP(6  ) + (size_t)layer * SB * PAST * 1024;
#pragma unroll 2
      for (size_t i = gt; i < (size_t)SB * PAST * 128; i += NT) { const size_t b = i / (PAST * 128), rem = i % (PAST * 128);
          cvt8(sk + i * 8, WSB(WS_KS) + b * LKSP * 1024 + rem * 8); cvt8(sv + i * 8, WSB(WS_VS) + b * LKSP * 1024 + rem * 8); } }
    { const float* sk = INP(7  ) + (size_t)layer * SB * NMEM * 1024; const float* sv = INP(8  ) + (size_t)layer * SB * NMEM * 1024;
#pragma unroll 2
      for (size_t i = gt; i < (size_t)SB * NMEM * 128; i += NT) { cvt8(sk + i * 8, WSB(WS_MKS) + i * 8); cvt8(sv + i * 8, WSB(WS_MVS) + i * 8); } }
}

#define MFMA32(a, b, c) __builtin_amdgcn_mfma_f32_32x32x16_bf16((a), (b), (c), 0, 0, 0)
constexpr int SSD_YB = 17408;
constexpr int SSD_SM_OFF = 8 * SSD_YB;
constexpr int SSD_RS_OFF = SSD_SM_OFF + 8 * 768;
static_assert(SSD_RS_OFF + 2048 <= RING_BYTES, "SSD LDS map");
struct SsdUnit { int b, c, g, row0, len, ck; bool smp; };
__device__ __forceinline__ SsdUnit ssd_unit(int u) {
    SsdUnit s; s.smp = u >= NB * NCH * NG;
    if (!s.smp) { s.b = u >> 8; s.c = (u >> 2) & (NCH - 1); s.g = u & 3; s.row0 = s.b * SEQ + s.c * 64; s.len = 64; s.ck = s.row0 >> 6; }
    else { const int v = u - NB * NCH * NG; s.b = v >> 2; s.c = 0; s.g = v & 3; s.row0 = MP + s.b * SL; s.len = SL; s.ck = MP / 64 + s.b; }
    return s;
}
constexpr int NSSD_UNITS = NB * NCH * NG + SB * NG;
__device__ __forceinline__ void ssd_dt_cum_l(const Frame& F, const float* a_log_l, const SsdUnit& s, int hd, int lane, float& dtv, float& cum, float& clast) {
    dtv = lane < s.len ? WSF(WS_DT)[(size_t)(s.row0 + lane) * 32 + hd] : 0.f;
    const float Ah = -__expf(a_log_l[hd]);
    cum = dtv * Ah;
#pragma unroll
    for (int o = 1; o < 64; o <<= 1) { const float t = shl_from(cum, lane - o); if (lane >= o) cum += t; }
    clast = shl_from(cum, 63);
}
__device__ __forceinline__ void ssd_dt_cum(const Frame& F, const float* a_log_l, const SsdUnit& s, int hd, float& dtv, float& cum, float& clast) { ssd_dt_cum_l(F, a_log_l, s, hd, F.lane, dtv, cum, clast); }
__device__ __forceinline__ bf16x8 scale_bf8(const v4u raw, const f32x4 w0, const f32x4 w1) {
    v4u o; o.x = pk2(bflo(raw.x) * w0.x, bfhi(raw.x) * w0.y); o.y = pk2(bflo(raw.y) * w0.z, bfhi(raw.y) * w0.w);
    o.z = pk2(bflo(raw.z) * w1.x, bfhi(raw.z) * w1.y); o.w = pk2(bflo(raw.w) * w1.z, bfhi(raw.w) * w1.w); return __builtin_bit_cast(bf16x8, o); }
__device__ __forceinline__ bf16x8 f8_to_bf8(const float* p) {
    const f32x4 a = *(const GAS f32x4*)p, b = *(const GAS f32x4*)(p + 4); v4u o; o.x = pk2(a.x, a.y); o.y = pk2(a.z, a.w); o.z = pk2(b.x, b.y); o.w = pk2(b.z, b.w); return __builtin_bit_cast(bf16x8, o); }

__device__ __forceinline__ void ssd_pass_a(Frame& F, int layer, int u0, int u1, int ustep) {
    const int lane = F.lane, r = lane & 31, hh = lane >> 5;
    LAS float* wb = (LAS float*)(F.lds + SSD_SM_OFF) + F.wave * 192;
    const float zf = zero_asm();
    const float* a_log_l = INP(15) + layer * NH; const float* state_ssm = INP(4);
#pragma unroll 1
    for (int u = u0; u < u1; u += ustep) {
        const SsdUnit s = ssd_unit(u); const int hd = s.g * 8 + F.wave;
        float dtv, cum, cl; ssd_dt_cum(F, a_log_l, s, hd, dtv, cum, cl);
        wb[lane] = dtv * fexp(cl - cum);
        LDS_WAIT(); asm volatile("" ::: "memory");
        f32x16 acc[4][2];
#pragma unroll
        for (int nt = 0; nt < 4; ++nt)
#pragma unroll
            for (int pt = 0; pt < 2; ++pt)
#pragma unroll
                for (int e = 0; e < 16; ++e) acc[nt][pt][e] = zf;
        const bf16* xt = WSB(WS_XT) + ((size_t)s.ck * DSSM + hd * 64 + r) * 64 + 8 * hh;
        const bf16* bt = WSB(WS_BT) + ((size_t)s.ck * GB + s.g * DST + r) * 64 + 8 * hh;
#pragma unroll
        for (int ks = 0; ks < 4; ++ks) {
            const f32x4 w0 = *(const LAS f32x4*)(wb + 16 * ks + 8 * hh), w1 = *(const LAS f32x4*)(wb + 16 * ks + 8 * hh + 4);
            bf16x8 a[2], bb[4];
#pragma unroll
            for (int pt = 0; pt < 2; ++pt) a[pt] = scale_bf8(*(const GAS v4u*)(xt + (32 * pt) * 64 + 16 * ks), w0, w1);
#pragma unroll
            for (int nt = 0; nt < 4; ++nt) bb[nt] = *(const GAS bf16x8*)(bt + (32 * nt) * 64 + 16 * ks);
#pragma unroll
            for (int nt = 0; nt < 4; ++nt)
#pragma unroll
                for (int pt = 0; pt < 2; ++pt) acc[nt][pt] = MFMA32(bb[nt], a[pt], acc[nt][pt]);
        }
        const float dc = fexp(cl);
        int ro = r * DST + 4 * hh; asm volatile("" : "+v"(ro));
        if (!s.smp) {
            LAS unsigned char* tb = F.lds + F.wave * SSD_YB;
#pragma unroll
            for (int nt = 0; nt < 4; ++nt)
#pragma unroll
                for (int pt = 0; pt < 2; ++pt)
#pragma unroll
                    for (int q4 = 0; q4 < 4; ++q4) { v2u o; o.x = pk2(acc[nt][pt][4 * q4], acc[nt][pt][4 * q4 + 1]); o.y = pk2(acc[nt][pt][4 * q4 + 2], acc[nt][pt][4 * q4 + 3]);
                        *(LAS v2u*)(tb + (32 * pt + r) * 272 + (32 * nt + 8 * q4 + 4 * hh) * 2) = o; }
            LDS_WAIT(); asm volatile("" ::: "memory");
            bf16* st = WSB(WS_ST) + (size_t)((s.b * NCH + s.c) * NH + hd) * 8192 + lane * 8;
#pragma unroll
            for (int it = 0; it < 16; ++it) *(GAS v4u*)(st + it * 512) = *(const LAS v4u*)(tb + (32 * (it & 1) + r) * 272 + (16 * (it >> 1) + 8 * hh) * 2);
            LDS_WAIT(); asm volatile("" ::: "memory");
            if (lane == 0) WSF(WS_DC)[(s.b * NCH + s.c) * NH + hd] = dc;
        } else {
            const size_t base = ((size_t)(layer * SB + s.b) * NH + hd) * 8192 + ro;
            const float* h0 = state_ssm + base; float* ho = (float*)(F.out + O_SSSM + base);
#pragma unroll
            for (int nt = 0; nt < 4; ++nt) {
#pragma unroll
                for (int pt = 0; pt < 2; ++pt)
#pragma unroll
                    for (int q4 = 0; q4 < 4; ++q4) { const int o = (32 * pt) * DST + 32 * nt + 8 * q4; const f32x4 hv = *(const GAS f32x4*)(h0 + o);
                        *(GAS f32x4*)(ho + o) = (f32x4){hv.x * dc + acc[nt][pt][4 * q4], hv.y * dc + acc[nt][pt][4 * q4 + 1], hv.z * dc + acc[nt][pt][4 * q4 + 2], hv.w * dc + acc[nt][pt][4 * q4 + 3]}; }
                __builtin_amdgcn_sched_barrier(0); }
        }
        LDS_WAIT(); asm volatile("" ::: "memory");
    }
}

__device__ __forceinline__ void ssd_pass_b(Frame& F, int layer) {
    const size_t gt = (size_t)F.bx * (NWAVES * 64) + F.tid, NT = (size_t)F.G * (NWAVES * 64);
#pragma unroll 1
    for (size_t idx = gt; idx < (size_t)NB * NH * 1024; idx += NT) {
        const int bh = (int)(idx >> 10), e8 = (int)(idx & 1023), b = bh >> 5, hd = bh & 31;
        GAS v4u* p = (GAS v4u*)WSB(WS_ST) + ((size_t)(b * NCH) * NH + hd) * 1024 + e8;
        const float* dcp = WSF(WS_DC) + (b * NCH) * NH + hd;
        const float zf = zero_asm(); float h[8];
#pragma unroll
        for (int k = 0; k < 8; ++k) h[k] = zf;
#pragma unroll 1
        for (int c0 = 0; c0 < NCH; c0 += 8) {
            v4u t[8]; float d[8];
#pragma unroll
            for (int j = 0; j < 8; ++j) { t[j] = p[(size_t)j * NH * 1024]; d[j] = dcp[j * NH]; }
#pragma unroll
            for (int j = 0; j < 8; ++j) { v4u o; o.x = pk2(h[0], h[1]); o.y = pk2(h[2], h[3]); o.z = pk2(h[4], h[5]); o.w = pk2(h[6], h[7]); p[(size_t)j * NH * 1024] = o;
                h[0] = h[0] * d[j] + bflo(t[j].x); h[1] = h[1] * d[j] + bfhi(t[j].x); h[2] = h[2] * d[j] + bflo(t[j].y); h[3] = h[3] * d[j] + bfhi(t[j].y);
                h[4] = h[4] * d[j] + bflo(t[j].z); h[5] = h[5] * d[j] + bfhi(t[j].z); h[6] = h[6] * d[j] + bflo(t[j].w); h[7] = h[7] * d[j] + bfhi(t[j].w); }
            p += (size_t)8 * NH * 1024; dcp += 8 * NH;
        }
        const int pp = 32 * ((e8 >> 6) & 1) + (e8 & 31), nn = 16 * (e8 >> 7) + 8 * ((e8 >> 5) & 1);
        GAS f32x4* po = (GAS f32x4*)(F.out + O_PSSM) + ((size_t)(layer * NB + b) * NH + hd) * 2048 + pp * 32 + (nn >> 2);
        po[0] = (f32x4){h[0], h[1], h[2], h[3]}; po[1] = (f32x4){h[4], h[5], h[6], h[7]};
    }
}

__device__ __forceinline__ void ssd_pass_c(Frame& F, int layer, int u0, int u1, int ustep) {
    LAS float* cumb = (LAS float*)(F.lds + SSD_SM_OFF) + F.wave * 192; LAS float* dtb = cumb + 64; LAS float* ecb = cumb + 128;
    LAS float* yb = (LAS float*)(F.lds + F.wave * SSD_YB);
    LAS float* rsq = (LAS float*)(F.lds + SSD_RS_OFF);
    const float zf = zero_asm();
    const float* a_log_l = INP(15) + layer * NH; const float* state_ssm = INP(4); const float* d_skip_l = INP(16) + layer * NH; const float* ssm_norm_w_l = INP(17) + layer * DSSM;
#pragma unroll 1
    for (int u = u0; u < u1; u += ustep) {
        int lane = F.lane; asm volatile("" : "+v"(lane));
        const int r = lane & 31, hh = lane >> 5;
        const SsdUnit s = ssd_unit(u); const int hd = s.g * 8 + F.wave;
        float dtv, cum, cl; ssd_dt_cum(F, a_log_l, s, hd, dtv, cum, cl);
        cumb[lane] = cum; dtb[lane] = dtv; ecb[lane] = fexp(cum);
        LDS_WAIT(); asm volatile("" ::: "memory");
        f32x16 acc[2][2];
#pragma unroll
        for (int lt = 0; lt < 2; ++lt)
#pragma unroll
            for (int pt = 0; pt < 2; ++pt)
#pragma unroll
                for (int e = 0; e < 16; ++e) acc[lt][pt][e] = zf;
        const bf16* ctk = WSB(WS_CTOK) + (size_t)(s.row0 + r) * GB + s.g * DST + 8 * hh;
        const bf16* btk = WSB(WS_BTOK) + (size_t)(s.row0 + r) * GB + s.g * DST + 8 * hh;
        const float* hps = state_ssm + ((size_t)(layer * SB + (s.smp ? s.b : 0)) * NH + hd) * 8192 + (size_t)r * DST + 8 * hh;
        const bf16* hpp = WSB(WS_ST) + (size_t)(s.smp ? 0 : ((s.b * NCH + s.c) * NH + hd)) * 8192 + lane * 8;
#pragma unroll
        for (int ks = 0; ks < 8; ++ks) {
            bf16x8 cf[2], hf[2];
#pragma unroll
            for (int lt = 0; lt < 2; ++lt) cf[lt] = *(const GAS bf16x8*)(ctk + (size_t)(32 * lt) * GB + 16 * ks);
#pragma unroll
            for (int pt = 0; pt < 2; ++pt) hf[pt] = s.smp ? f8_to_bf8(hps + (32 * pt) * DST + 16 * ks) : *(const GAS bf16x8*)(hpp + (2 * ks + pt) * 512);
#pragma unroll
            for (int lt = 0; lt < 2; ++lt)
#pragma unroll
                for (int pt = 0; pt < 2; ++pt) acc[lt][pt] = MFMA32(cf[lt], hf[pt], acc[lt][pt]);
        }
#pragma unroll
        for (int lt = 0; lt < 2; ++lt)
#pragma unroll
            for (int q4 = 0; q4 < 4; ++q4) { const f32x4 sc4 = *(const LAS f32x4*)(ecb + 32 * lt + 8 * q4 + 4 * hh);
#pragma unroll
                for (int j = 0; j < 4; ++j) { acc[lt][0][4 * q4 + j] *= sc4[j]; acc[lt][1][4 * q4 + j] *= sc4[j]; } }
        f32x16 T00, T01, T11;
#pragma unroll
        for (int e = 0; e < 16; ++e) { T00[e] = zf; T01[e] = zf; T11[e] = zf; }
#pragma unroll
        for (int ks = 0; ks < 8; ++ks) {
            const bf16x8 b0 = *(const GAS bf16x8*)(btk + 16 * ks), b1 = *(const GAS bf16x8*)(btk + (size_t)32 * GB + 16 * ks);
            const bf16x8 c0 = *(const GAS bf16x8*)(ctk + 16 * ks), c1 = *(const GAS bf16x8*)(ctk + (size_t)32 * GB + 16 * ks);
            T00 = MFMA32(b0, c0, T00); T01 = MFMA32(b0, c1, T01); T11 = MFMA32(b1, c1, T11);
        }
        const float cl0 = cumb[r], cl1 = cumb[32 + r];
#pragma unroll
        for (int q4 = 0; q4 < 4; ++q4) { const int s0 = 8 * q4 + 4 * hh;
            const f32x4 cs0v = *(const LAS f32x4*)(cumb + s0), cs1v = *(const LAS f32x4*)(cumb + 32 + s0), d0v = *(const LAS f32x4*)(dtb + s0), d1v = *(const LAS f32x4*)(dtb + 32 + s0);
#pragma unroll
            for (int j = 0; j < 4; ++j) { const int e = 4 * q4 + j, si = s0 + j;
                T00[e] = (si <= r) ? T00[e] * fexp(fminf(cl0 - cs0v[j], 0.f)) * d0v[j] : 0.f;
                T01[e] = T01[e] * fexp(fminf(cl1 - cs0v[j], 0.f)) * d0v[j];
                T11[e] = (si <= r) ? T11[e] * fexp(fminf(cl1 - cs1v[j], 0.f)) * d1v[j] : 0.f; } }
        const bf16* xt = WSB(WS_XT) + ((size_t)s.ck * DSSM + hd * 64 + r) * 64 + 4 * hh;
#pragma unroll
        for (int sp = 0; sp < 2; ++sp) {
            v4u w00, w01, w11;
            w00.x = pk2(T00[8 * sp + 0], T00[8 * sp + 1]); w00.y = pk2(T00[8 * sp + 2], T00[8 * sp + 3]); w00.z = pk2(T00[8 * sp + 4], T00[8 * sp + 5]); w00.w = pk2(T00[8 * sp + 6], T00[8 * sp + 7]);
            w01.x = pk2(T01[8 * sp + 0], T01[8 * sp + 1]); w01.y = pk2(T01[8 * sp + 2], T01[8 * sp + 3]); w01.z = pk2(T01[8 * sp + 4], T01[8 * sp + 5]); w01.w = pk2(T01[8 * sp + 6], T01[8 * sp + 7]);
            w11.x = pk2(T11[8 * sp + 0], T11[8 * sp + 1]); w11.y = pk2(T11[8 * sp + 2], T11[8 * sp + 3]); w11.z = pk2(T11[8 * sp + 4], T11[8 * sp + 5]); w11.w = pk2(T11[8 * sp + 6], T11[8 * sp + 7]);
#pragma unroll
            for (int pt = 0; pt < 2; ++pt) {
                const bf16* xp = xt + (32 * pt) * 64 + 16 * sp;
                const v2u x0a = *(const GAS v2u*)(xp), x0b = *(const GAS v2u*)(xp + 8), x1a = *(const GAS v2u*)(xp + 32), x1b = *(const GAS v2u*)(xp + 40);
                const bf16x8 xs0 = __builtin_bit_cast(bf16x8, (v4u){x0a.x, x0a.y, x0b.x, x0b.y}), xs1 = __builtin_bit_cast(bf16x8, (v4u){x1a.x, x1a.y, x1b.x, x1b.y});
                acc[0][pt] = MFMA32(__builtin_bit_cast(bf16x8, w00), xs0, acc[0][pt]);
                acc[1][pt] = MFMA32(__builtin_bit_cast(bf16x8, w01), xs0, acc[1][pt]);
                acc[1][pt] = MFMA32(__builtin_bit_cast(bf16x8, w11), xs1, acc[1][pt]);
            }
        }
        const float Dh = d_skip_l[hd];
#pragma unroll
        for (int lt = 0; lt < 2; ++lt)
#pragma unroll
            for (int pt = 0; pt < 2; ++pt)
#pragma unroll
                for (int q4 = 0; q4 < 4; ++q4) { const v2u xv = *(const GAS v2u*)(xt + (32 * pt) * 64 + 32 * lt + 8 * q4);
                    const int l0 = 32 * lt + 8 * q4 + 4 * hh;
                    yb[(l0 + 0) * 68 + 32 * pt + r] = acc[lt][pt][4 * q4 + 0] + Dh * bflo(xv.x);
                    yb[(l0 + 1) * 68 + 32 * pt + r] = acc[lt][pt][4 * q4 + 1] + Dh * bfhi(xv.x);
                    yb[(l0 + 2) * 68 + 32 * pt + r] = acc[lt][pt][4 * q4 + 2] + Dh * bflo(xv.y);
                    yb[(l0 + 3) * 68 + 32 * pt + r] = acc[lt][pt][4 * q4 + 3] + Dh * bfhi(xv.y); }
        LDS_WAIT(); asm volatile("" ::: "memory");
        const int p8 = (lane & 7) * 8; const bf16* zp = WSB(WS_Z) + (size_t)s.row0 * DSSM + hd * 64 + p8;
#pragma unroll
        for (int it = 0; it < 8; ++it) { const int row = it * 8 + (lane >> 3);
            f32x4 y0 = *(const LAS f32x4*)(yb + row * 68 + p8), y1 = *(const LAS f32x4*)(yb + row * 68 + p8 + 4);
            v4u zr; { const unsigned zu = __builtin_bit_cast(unsigned, zf); zr = (v4u){zu, zu, zu, zu}; } if (row < s.len) zr = *(const GAS v4u*)(zp + (size_t)row * DSSM);
            y0.x *= silu(bflo(zr.x)); y0.y *= silu(bfhi(zr.x)); y0.z *= silu(bflo(zr.y)); y0.w *= silu(bfhi(zr.y));
            y1.x *= silu(bflo(zr.z)); y1.y *= silu(bfhi(zr.z)); y1.z *= silu(bflo(zr.w)); y1.w *= silu(bfhi(zr.w));
            *(LAS f32x4*)(yb + row * 68 + p8) = y0; *(LAS f32x4*)(yb + row * 68 + p8 + 4) = y1;
            float ss = (y0.x * y0.x + y0.y * y0.y) + (y0.z * y0.z + y0.w * y0.w) + (y1.x * y1.x + y1.y * y1.y) + (y1.z * y1.z + y1.w * y1.w);
            ss += shx(ss, lane, 1); ss += shx(ss, lane, 2); ss += shx(ss, lane, 4);
            if ((lane & 7) == 0) rsq[F.wave * 64 + row] = ss; }
        __syncthreads();
        const f32x4 nw0 = *(const GAS f32x4*)(ssm_norm_w_l + hd * 64 + p8), nw1 = *(const GAS f32x4*)(ssm_norm_w_l + hd * 64 + p8 + 4);
        bf16* yo = WSB(WS_Y) + (size_t)s.row0 * DM + hd * 64 + p8;
#pragma unroll
        for (int it = 0; it < 8; ++it) { const int row = it * 8 + (lane >> 3);
            float tot = 0.f;
#pragma unroll
            for (int w = 0; w < 8; ++w) tot += rsq[w * 64 + row];
            const float rstd = __builtin_amdgcn_rsqf(tot * (1.f / 512.f) + NORM_EPS);
            const f32x4 y0 = *(const LAS f32x4*)(yb + row * 68 + p8), y1 = *(const LAS f32x4*)(yb + row * 68 + p8 + 4);
            if (row < s.len) { v4u o; o.x = pk2(y0.x * rstd * nw0.x, y0.y * rstd * nw0.y); o.y = pk2(y0.z * rstd * nw0.z, y0.w * rstd * nw0.w);
                o.z = pk2(y1.x * rstd * nw1.x, y1.y * rstd * nw1.y); o.w = pk2(y1.z * rstd * nw1.z, y1.w * rstd * nw1.w);
                *(GAS v4u*)(yo + (size_t)row * DM) = o; } }
        __syncthreads();
    }
}

__device__ __forceinline__ void ssd_pass_c_prompt(Frame& F, int layer, int u0, int u1, int ustep) {
    LAS float* cumb = (LAS float*)(F.lds + SSD_SM_OFF) + F.wave * 192; LAS float* dtb = cumb + 64; LAS float* ecb = cumb + 128;
    LAS float* yb = (LAS float*)(F.lds + F.wave * SSD_YB);
    LAS float* rsq = (LAS float*)(F.lds + SSD_RS_OFF);
    const float* a_log_l = INP(15) + layer * NH; const float* d_skip_l = INP(16) + layer * NH; const float* ssm_norm_w_l = INP(17) + layer * DSSM;
#pragma unroll 1
    for (int u = u0; u < u1; u += ustep) {
        int lane = F.lane; asm volatile("" : "+v"(lane));
        const int r = lane & 31, hh = lane >> 5;
        const SsdUnit s = ssd_unit(u); const int hd = s.g * 8 + F.wave;
        const bf16* hpp = WSB(WS_ST) + (size_t)((s.b * NCH + s.c) * NH + hd) * 8192 + lane * 8;
        const bf16* xt = WSB(WS_XT) + ((size_t)s.ck * DSSM + hd * 64 + r) * 64 + 4 * hh;
        const int p8 = (lane & 7) * 8; const bf16* zp = WSB(WS_Z) + (size_t)s.row0 * DSSM + hd * 64 + p8;
        LAS unsigned char* ctl = F.lds; LAS unsigned char* btl = F.lds + SSD_YB;
        const int q0 = F.wave * 64 + lane;
        v4u sc[2], sb[2];
#pragma unroll
        for (int j = 0; j < 2; ++j) { const int q = q0 + 512 * j; const size_t go = (size_t)(s.row0 + (q >> 4)) * GB + s.g * DST + (q & 15) * 8;
            sc[j] = *(const GAS v4u*)(WSB(WS_CTOK) + go); sb[j] = *(const GAS v4u*)(WSB(WS_BTOK) + go); }
        bf16x8 hf[8][2];
#pragma unroll
        for (int ks = 0; ks < 8; ++ks)
#pragma unroll
            for (int t = 0; t < 2; ++t) hf[ks][t] = *(const GAS bf16x8*)(hpp + (2 * ks + t) * 512);
        __builtin_amdgcn_sched_barrier(0);
        float dtv, cum, cl; ssd_dt_cum_l(F, a_log_l, s, hd, lane, dtv, cum, cl);
        cumb[lane] = cum; dtb[lane] = dtv; ecb[lane] = fexp(cum);
#pragma unroll
        for (int j = 0; j < 2; ++j) { const int q = q0 + 512 * j; *(LAS v4u*)(ctl + (q >> 4) * 272 + (q & 15) * 16) = sc[j]; *(LAS v4u*)(btl + (q >> 4) * 272 + (q & 15) * 16) = sb[j]; }
        LDS_WAIT(); __builtin_amdgcn_s_barrier(); asm volatile("" ::: "memory");
        const f32x16 z16 = {0.f, 0.f, 0.f, 0.f, 0.f, 0.f, 0.f, 0.f, 0.f, 0.f, 0.f, 0.f, 0.f, 0.f, 0.f, 0.f};
        f32x16 T00, T01, T11, acc[2][2];
        const LAS unsigned char* cfr = ctl + r * 272 + 16 * hh; const LAS unsigned char* bfr = btl + r * 272 + 16 * hh;
#pragma unroll
        for (int ks = 0; ks < 8; ++ks) {
            const bf16x8 c0 = *(const LAS bf16x8*)(cfr + 32 * ks), c1 = *(const LAS bf16x8*)(cfr + 32 * 272 + 32 * ks), g0 = *(const LAS bf16x8*)(bfr + 32 * ks), g1 = *(const LAS bf16x8*)(bfr + 32 * 272 + 32 * ks);
            if (ks == 0) { T00 = MFMA32(g0, c0, z16); T01 = MFMA32(g0, c1, z16); T11 = MFMA32(g1, c1, z16);
                acc[0][0] = MFMA32(c0, hf[0][0], z16); acc[0][1] = MFMA32(c0, hf[0][1], z16); acc[1][0] = MFMA32(c1, hf[0][0], z16); acc[1][1] = MFMA32(c1, hf[0][1], z16); }
            else { T00 = MFMA32(g0, c0, T00); T01 = MFMA32(g0, c1, T01); T11 = MFMA32(g1, c1, T11);
                acc[0][0] = MFMA32(c0, hf[ks][0], acc[0][0]); acc[0][1] = MFMA32(c0, hf[ks][1], acc[0][1]); acc[1][0] = MFMA32(c1, hf[ks][0], acc[1][0]); acc[1][1] = MFMA32(c1, hf[ks][1], acc[1][1]); }
        }
        __builtin_amdgcn_sched_barrier(0);
        v2u xv[2][2][4]; v4u zr[8];
#pragma unroll
        for (int pt = 0; pt < 2; ++pt)
#pragma unroll
            for (int lt = 0; lt < 2; ++lt)
#pragma unroll
                for (int q4 = 0; q4 < 4; ++q4) xv[pt][lt][q4] = *(const GAS v2u*)(xt + (32 * pt) * 64 + 32 * lt + 8 * q4);
        LDS_WAIT(); __builtin_amdgcn_s_barrier(); asm volatile("" ::: "memory");
        const float cl0 = cumb[r], cl1 = cumb[32 + r];
#pragma unroll
        for (int q4 = 0; q4 < 4; ++q4) { const int s0 = 8 * q4 + 4 * hh;
            const f32x4 cs0v = *(const LAS f32x4*)(cumb + s0), cs1v = *(const LAS f32x4*)(cumb + 32 + s0), d0v = *(const LAS f32x4*)(dtb + s0), d1v = *(const LAS f32x4*)(dtb + 32 + s0);
#pragma unroll
            for (int j = 0; j < 4; ++j) { const int e = 4 * q4 + j, si = s0 + j;
                T00[e] = (si <= r) ? T00[e] * fexp(fminf(cl0 - cs0v[j], 0.f)) * d0v[j] : 0.f;
                T01[e] = T01[e] * fexp(fminf(cl1 - cs0v[j], 0.f)) * d0v[j];
                T11[e] = (si <= r) ? T11[e] * fexp(fminf(cl1 - cs1v[j], 0.f)) * d1v[j] : 0.f; } }
        v4u w00[2], w01[2], w11[2];
#pragma unroll
        for (int sp = 0; sp < 2; ++sp) {
            w00[sp].x = pk2(T00[8 * sp + 0], T00[8 * sp + 1]); w00[sp].y = pk2(T00[8 * sp + 2], T00[8 * sp + 3]); w00[sp].z = pk2(T00[8 * sp + 4], T00[8 * sp + 5]); w00[sp].w = pk2(T00[8 * sp + 6], T00[8 * sp + 7]);
            w01[sp].x = pk2(T01[8 * sp + 0], T01[8 * sp + 1]); w01[sp].y = pk2(T01[8 * sp + 2], T01[8 * sp + 3]); w01[sp].z = pk2(T01[8 * sp + 4], T01[8 * sp + 5]); w01[sp].w = pk2(T01[8 * sp + 6], T01[8 * sp + 7]);
            w11[sp].x = pk2(T11[8 * sp + 0], T11[8 * sp + 1]); w11[sp].y = pk2(T11[8 * sp + 2], T11[8 * sp + 3]); w11[sp].z = pk2(T11[8 * sp + 4], T11[8 * sp + 5]); w11[sp].w = pk2(T11[8 * sp + 6], T11[8 * sp + 7]); }
        __builtin_amdgcn_sched_barrier(0);
#pragma unroll
        for (int it = 0; it < 8; ++it) zr[it] = *(const GAS v4u*)(zp + (size_t)(it * 8 + (lane >> 3)) * DSSM);
        __builtin_amdgcn_sched_barrier(0);
#pragma unroll
        for (int lt = 0; lt < 2; ++lt)
#pragma unroll
            for (int q4 = 0; q4 < 4; ++q4) { const f32x4 sc4 = *(const LAS f32x4*)(ecb + 32 * lt + 8 * q4 + 4 * hh);
#pragma unroll
                for (int j = 0; j < 4; ++j) { acc[lt][0][4 * q4 + j] *= sc4[j]; acc[lt][1][4 * q4 + j] *= sc4[j]; } }
#pragma unroll
        for (int sp = 0; sp < 2; ++sp) {
#pragma unroll
            for (int pt = 0; pt < 2; ++pt) {
                const v2u x0a = xv[pt][0][2 * sp], x0b = xv[pt][0][2 * sp + 1], x1a = xv[pt][1][2 * sp], x1b = xv[pt][1][2 * sp + 1];
                const bf16x8 xs0 = __builtin_bit_cast(bf16x8, (v4u){x0a.x, x0a.y, x0b.x, x0b.y}), xs1 = __builtin_bit_cast(bf16x8, (v4u){x1a.x, x1a.y, x1b.x, x1b.y});
                acc[0][pt] = MFMA32(__builtin_bit_cast(bf16x8, w00[sp]), xs0, acc[0][pt]);
                acc[1][pt] = MFMA32(__builtin_bit_cast(bf16x8, w01[sp]), xs0, acc[1][pt]);
                acc[1][pt] = MFMA32(__builtin_bit_cast(bf16x8, w11[sp]), xs1, acc[1][pt]);
            }
        }
        const float Dh = d_skip_l[hd];
#pragma unroll
        for (int lt = 0; lt < 2; ++lt)
#pragma unroll
            for (int pt = 0; pt < 2; ++pt)
#pragma unroll
                for (int q4 = 0; q4 < 4; ++q4) { const v2u xq = xv[pt][lt][q4];
                    const int l0 = 32 * lt + 8 * q4 + 4 * hh;
                    yb[(l0 + 0) * 68 + 32 * pt + r] = acc[lt][pt][4 * q4 + 0] + Dh * bflo(xq.x);
                    yb[(l0 + 1) * 68 + 32 * pt + r] = acc[lt][pt][4 * q4 + 1] + Dh * bfhi(xq.x);
                    yb[(l0 + 2) * 68 + 32 * pt + r] = acc[lt][pt][4 * q4 + 2] + Dh * bflo(xq.y);
                    yb[(l0 + 3) * 68 + 32 * pt + r] = acc[lt][pt][4 * q4 + 3] + Dh * bfhi(xq.y); }
        LDS_WAIT(); asm volatile("" ::: "memory");
#pragma unroll
        for (int it = 0; it < 8; ++it) { const int row = it * 8 + (lane >> 3);
            f32x4 y0 = *(const LAS f32x4*)(yb + row * 68 + p8), y1 = *(const LAS f32x4*)(yb + row * 68 + p8 + 4);
            const v4u zq = zr[it];
            y0.x *= silu(bflo(zq.x)); y0.y *= silu(bfhi(zq.x)); y0.z *= silu(bflo(zq.y)); y0.w *= silu(bfhi(zq.y));
            y1.x *= silu(bflo(zq.z)); y1.y *= silu(bfhi(zq.z)); y1.z *= silu(bflo(zq.w)); y1.w *= silu(bfhi(zq.w));
            *(LAS f32x4*)(yb + row * 68 + p8) = y0; *(LAS f32x4*)(yb + row * 68 + p8 + 4) = y1;
            float ss = (y0.x * y0.x + y0.y * y0.y) + (y0.z * y0.z + y0.w * y0.w) + (y1.x * y1.x + y1.y * y1.y) + (y1.z * y1.z + y1.w * y1.w);
            ss += shx(ss, lane, 1); ss += shx(ss, lane, 2); ss += shx(ss, lane, 4);
            if ((lane & 7) == 0) rsq[F.wave * 64 + row] = ss; }
        __syncthreads();
        const f32x4 nw0 = *(const GAS f32x4*)(ssm_norm_w_l + hd * 64 + p8), nw1 = *(const GAS f32x4*)(ssm_norm_w_l + hd * 64 + p8 + 4);
        bf16* yo = WSB(WS_Y) + (size_t)s.row0 * DM + hd * 64 + p8;
#pragma unroll
        for (int it = 0; it < 8; ++it) { const int row = it * 8 + (lane >> 3);
            float tot = 0.f;
#pragma unroll
            for (int w = 0; w < 8; ++w) tot += rsq[w * 64 + row];
            const float rstd = __builtin_amdgcn_rsqf(tot * (1.f / 512.f) + NORM_EPS);
            const f32x4 y0 = *(const LAS f32x4*)(yb + row * 68 + p8), y1 = *(const LAS f32x4*)(yb + row * 68 + p8 + 4);
            v4u o; o.x = pk2(y0.x * rstd * nw0.x, y0.y * rstd * nw0.y); o.y = pk2(y0.z * rstd * nw0.z, y0.w * rstd * nw0.w);
            o.z = pk2(y1.x * rstd * nw1.x, y1.y * rstd * nw1.y); o.w = pk2(y1.z * rstd * nw1.z, y1.w * rstd * nw1.w);
            *(GAS v4u*)(yo + (size_t)row * DM) = o; }
        __syncthreads();
    }
}

#define MFMA16(a, b, c) __builtin_amdgcn_mfma_f32_16x16x32_bf16((a), (b), (c), 0, 0, 0)
typedef short v4i16_t __attribute__((ext_vector_type(4)));
__device__ __forceinline__ s16x4 vtr(const LAS unsigned char* p) { return __builtin_bit_cast(s16x4, __builtin_amdgcn_ds_read_tr16_b64_v4i16((LAS v4i16_t*)p)); }
__device__ __forceinline__ void swap32(float& a, float& b) { asm volatile("s_nop 1\n\tv_permlane32_swap_b32 %0, %1" : "+v"(a), "+v"(b)); }
__device__ __forceinline__ void swap16(float& a, float& b) { asm volatile("s_nop 1\n\tv_permlane16_swap_b32 %0, %1" : "+v"(a), "+v"(b)); }
__device__ __forceinline__ float swap32_max(float v) { float a = v, b = v; swap32(a, b); return fmaxf(a, b); }
__device__ __forceinline__ float swap32_sum(float v) { float a = v, b = v; swap32(a, b); return a + b; }
__device__ __forceinline__ float swap16_max(float v) { float a = v, b = v; swap16(a, b); return fmaxf(a, b); }
constexpr int AT_QS = 528, AT_KS = 528, AT_VS = 544;
constexpr int AT_Q0 = 0, AT_K0 = 128 * AT_QS, AT_KB = 32 * AT_KS, AT_V0 = AT_K0 + 2 * AT_KB, AT_VB = 32 * AT_VS;
static_assert(AT_V0 + 2 * AT_VB <= RING_BYTES, "attention LDS map");
struct AttnUnit { const bf16* Q; const bf16* K; const bf16* V; const bf16* Gt; bf16* Yo; int nq, ntiles, nvis_lo, nvis_hi, lk; };

template <bool DIFF>
__device__ __forceinline__ void attn_unit(Frame& F, const AttnUnit& U, float lam, float osc, const float* subw, float sc) {
    constexpr int NMAP = DIFF ? 2 : 1, NKS = DIFF ? 4 : 8;
    int lane = F.lane; asm volatile("" : "+v"(lane));
    const int w = F.wave, tid = w * 64 + lane, q16 = lane & 15, g = lane >> 4;
    LAS unsigned char* L = F.lds;
    const float zf = zero_asm();
#pragma unroll 1
    for (int ci = tid; ci < U.nq * 32; ci += NWAVES * 64) { const int row = ci >> 5, ch = ci & 31; *(LAS v4u*)(L + AT_Q0 + row * AT_QS + ch * 16) = *(const GAS v4u*)(U.Q + (size_t)row * 1024 + ch * 8); }
    const int r0 = tid >> 5, ch = tid & 31;
    v4u kr0, kr1, vr0, vr1;
    { const bf16* kp = U.K + (size_t)r0 * 1024 + ch * 8; const bf16* vp = U.V + (size_t)r0 * 1024 + ch * 8;
      kr0 = *(const GAS v4u*)kp; kr1 = *(const GAS v4u*)(kp + 16 * 1024); vr0 = *(const GAS v4u*)vp; vr1 = *(const GAS v4u*)(vp + 16 * 1024); }
    *(LAS v4u*)(L + AT_K0 + r0 * AT_KS + ch * 16) = kr0; *(LAS v4u*)(L + AT_K0 + (r0 + 16) * AT_KS + ch * 16) = kr1;
    *(LAS v4u*)(L + AT_V0 + r0 * AT_VS + ch * 16) = vr0; *(LAS v4u*)(L + AT_V0 + (r0 + 16) * AT_VS + ch * 16) = vr1;
    __syncthreads();
    const bool active = (16 * w) < U.nq;
    const int nvis = (w < 4) ? U.nvis_lo : U.nvis_hi;
    f32x4 O[NMAP][16];
#pragma unroll
    for (int m = 0; m < NMAP; ++m)
#pragma unroll
        for (int nt = 0; nt < 16; ++nt) O[m][nt] = (f32x4){zf, zf, zf, zf};
    float mrun[NMAP], lsum[NMAP];
#pragma unroll
    for (int m = 0; m < NMAP; ++m) { mrun[m] = -INFINITY; lsum[m] = zf; }
    const LAS unsigned char* Qb = L + AT_Q0 + (16 * w + q16) * AT_QS + 16 * g;
    const int kvoff = q16 * AT_KS + 16 * g;
    const int vtoff = (4 * g + (q16 >> 2)) * AT_VS + 8 * (lane & 3);
#pragma unroll 1
    for (int t = 0; t < U.ntiles; ++t) {
        const bool more = (t + 1) < U.ntiles;
        if (more) { const bf16* kp = U.K + (size_t)(32 * (t + 1) + r0) * 1024 + ch * 8; const bf16* vp = U.V + (size_t)(32 * (t + 1) + r0) * 1024 + ch * 8;
            kr0 = *(const GAS v4u*)kp; kr1 = *(const GAS v4u*)(kp + 16 * 1024); vr0 = *(const GAS v4u*)vp; vr1 = *(const GAS v4u*)(vp + 16 * 1024); }
        if (active && t < nvis) {
            const LAS unsigned char* Kb = L + AT_K0 + (t & 1) * AT_KB + kvoff; const LAS unsigned char* Vb = L + AT_V0 + (t & 1) * AT_VB + vtoff;
            f32x4 s[NMAP][2];
#pragma unroll
            for (int m = 0; m < NMAP; ++m) { s[m][0] = (f32x4){zf, zf, zf, zf}; s[m][1] = (f32x4){zf, zf, zf, zf}; }
            bf16x8 qA, kA0, kA1, qB, kB0, kB1;
#define AT_LDS(st, q, k0, k1) do { q = *(const LAS bf16x8*)(Qb + 64 * (st)); k0 = *(const LAS bf16x8*)(Kb + 64 * (st)); k1 = *(const LAS bf16x8*)(Kb + 16 * AT_KS + 64 * (st)); } while (0)
            AT_LDS(0, qA, kA0, kA1); AT_LDS(1, qB, kB0, kB1);
#pragma unroll
            for (int st = 0; st < 8; ++st) { const int m = DIFF ? (st >> 2) : 0;
                if ((st & 1) == 0) { s[m][0] = MFMA16(kA0, qA, s[m][0]); s[m][1] = MFMA16(kA1, qA, s[m][1]); if (st + 2 < 8) AT_LDS(st + 2, qA, kA0, kA1); }
                else { s[m][0] = MFMA16(kB0, qB, s[m][0]); s[m][1] = MFMA16(kB1, qB, s[m][1]); if (st + 2 < 8) AT_LDS(st + 2, qB, kB0, kB1); }
                __builtin_amdgcn_sched_barrier(0); }
#undef AT_LDS
            s16x4 vA0 = vtr(Vb), vA1 = vtr(Vb + 16 * AT_VS), vB0 = vtr(Vb + 32), vB1 = vtr(Vb + 16 * AT_VS + 32);
            bf16x8 pf[NMAP];
            const bool tail = (32 * t + 32) > U.lk;
#pragma unroll
            for (int m = 0; m < NMAP; ++m) {
                float p[8];
#pragma unroll
                for (int sub = 0; sub < 2; ++sub)
#pragma unroll
                    for (int e = 0; e < 4; ++e) p[4 * sub + e] = s[m][sub][e];
                if (tail) {
#pragma unroll
                    for (int sub = 0; sub < 2; ++sub)
#pragma unroll
                        for (int e = 0; e < 4; ++e) if (32 * t + 16 * sub + 4 * g + e >= U.lk) p[4 * sub + e] = -INFINITY;
                }
                float mx = fmaxf(fmaxf(fmaxf(p[0], p[1]), fmaxf(p[2], p[3])), fmaxf(fmaxf(p[4], p[5]), fmaxf(p[6], p[7])));
                mx = swap32_max(swap16_max(mx));
                mx *= sc;
                const float mn = fmaxf(mrun[m], mx); const float mref = (mn == -INFINITY) ? 0.f : mn;
                float ps = 0.f;
#pragma unroll
                for (int k = 0; k < 8; ++k) { p[k] = ex2(__builtin_fmaf(p[k], sc, -mref)); ps += p[k]; }
                if (!__all(mn == mrun[m])) {
                    const float alpha = ex2(mrun[m] - mref);
                    lsum[m] *= alpha;
#pragma unroll
                    for (int nt = 0; nt < 16; ++nt) O[m][nt] = O[m][nt] * alpha;
                }
                lsum[m] += ps; mrun[m] = mn;
                v4u pk; pk.x = pk2(p[0], p[1]); pk.y = pk2(p[2], p[3]); pk.z = pk2(p[4], p[5]); pk.w = pk2(p[6], p[7]); pf[m] = __builtin_bit_cast(bf16x8, pk);
            }
            __builtin_amdgcn_sched_barrier(0);
#pragma unroll
            for (int nt = 0; nt < 16; ++nt) {
                if ((nt & 1) == 0) { const bf16x8 vf = (bf16x8){vA0[0], vA0[1], vA0[2], vA0[3], vA1[0], vA1[1], vA1[2], vA1[3]};
#pragma unroll
                    for (int m = 0; m < NMAP; ++m) O[m][nt] = MFMA16(vf, pf[m], O[m][nt]);
                    if (nt + 2 < 16) { vA0 = vtr(Vb + 32 * (nt + 2)); vA1 = vtr(Vb + 16 * AT_VS + 32 * (nt + 2)); } }
                else { const bf16x8 vf = (bf16x8){vB0[0], vB0[1], vB0[2], vB0[3], vB1[0], vB1[1], vB1[2], vB1[3]};
#pragma unroll
                    for (int m = 0; m < NMAP; ++m) O[m][nt] = MFMA16(vf, pf[m], O[m][nt]);
                    if (nt + 2 < 16) { vB0 = vtr(Vb + 32 * (nt + 2)); vB1 = vtr(Vb + 16 * AT_VS + 32 * (nt + 2)); } }
                __builtin_amdgcn_sched_barrier(0);
            }
        }
        if (more) { const int bo = ((t + 1) & 1);
            *(LAS v4u*)(L + AT_K0 + bo * AT_KB + r0 * AT_KS + ch * 16) = kr0; *(LAS v4u*)(L + AT_K0 + bo * AT_KB + (r0 + 16) * AT_KS + ch * 16) = kr1;
            *(LAS v4u*)(L + AT_V0 + bo * AT_VB + r0 * AT_VS + ch * 16) = vr0; *(LAS v4u*)(L + AT_V0 + bo * AT_VB + (r0 + 16) * AT_VS + ch * 16) = vr1; }
        __syncthreads();
    }
    if (active) {
        float inv[NMAP];
#pragma unroll
        for (int m = 0; m < NMAP; ++m) { float l = lsum[m]; l += shx(l, lane, 16); l += shx(l, lane, 32); inv[m] = __builtin_amdgcn_rcpf(l); }
        LAS unsigned char* T = L + w * 8448;
        if constexpr (DIFF) {
            float ss = 0.f;
#pragma unroll
            for (int nt = 0; nt < 16; ++nt)
#pragma unroll
                for (int e = 0; e < 4; ++e) { const float o = O[0][nt][e] * inv[0] - lam * (O[1][nt][e] * inv[1]); O[0][nt][e] = o; ss += o * o; }
            ss += shx(ss, lane, 16); ss += shx(ss, lane, 32);
            const float rstd = osc * __builtin_amdgcn_rsqf(ss * (1.f / 256.f) + SUBLN_EPS);
#pragma unroll
            for (int nt = 0; nt < 16; ++nt) { const int d0 = 16 * nt + 4 * g; const f32x4 sw = *(const GAS f32x4*)(subw + d0);
                v2u o; o.x = pk2(O[0][nt][0] * rstd * sw.x, O[0][nt][1] * rstd * sw.y); o.y = pk2(O[0][nt][2] * rstd * sw.z, O[0][nt][3] * rstd * sw.w);
                *(LAS v2u*)(T + q16 * 528 + d0 * 2) = o; }
        } else {
#pragma unroll
            for (int nt = 0; nt < 16; ++nt) { const int d0 = 16 * nt + 4 * g;
                v2u o; o.x = pk2(O[0][nt][0] * inv[0], O[0][nt][1] * inv[0]); o.y = pk2(O[0][nt][2] * inv[0], O[0][nt][3] * inv[0]);
                *(LAS v2u*)(T + q16 * 528 + d0 * 2) = o; }
        }
        LDS_WAIT(); asm volatile("" ::: "memory");
        const int le = lane_id_asm(), rr = le >> 5, cc = (le & 31) * 8;
        v4u gt[8];
#pragma unroll
        for (int it = 0; it < 8; ++it) gt[it] = *(const GAS v4u*)(U.Gt + (size_t)(16 * w + 2 * it + rr) * 1024 + cc);
#pragma unroll
        for (int it = 0; it < 8; ++it) { const v4u y = *(const LAS v4u*)(T + (2 * it + rr) * 528 + cc * 2); const v4u gq = gt[it]; v4u o;
            o.x = pk2(bflo(y.x) * silu(bflo(gq.x)), bfhi(y.x) * silu(bfhi(gq.x))); o.y = pk2(bflo(y.y) * silu(bflo(gq.y)), bfhi(y.y) * silu(bfhi(gq.y)));
            o.z = pk2(bflo(y.z) * silu(bflo(gq.z)), bfhi(y.z) * silu(bfhi(gq.z))); o.w = pk2(bflo(y.w) * silu(bflo(gq.w)), bfhi(y.w) * silu(bfhi(gq.w)));
            *(GAS v4u*)(U.Yo + (size_t)(16 * w + 2 * it + rr) * DM + cc) = o; }
    }
}

constexpr int AB_KS = 528, AB_VS = 576, AB_KB = 32 * AB_KS, AB_K0 = 0, AB_V0 = 2 * AB_KB, AB_VB = 32 * AB_VS;
static_assert(AB_V0 + 2 * AB_VB <= RING_BYTES && 4 * 32768 <= RING_BYTES, "attention (32x32) LDS map");
__device__ __forceinline__ void attn_unit_b(Frame& F, const AttnUnit& U, float lam, float osc, const float* subw, float sc) {
    int lane = F.lane; asm volatile("" : "+v"(lane));
    const int w = F.wave, tid = w * 64 + lane, r = lane & 31, hh = lane >> 5, qg = w & 3, m = w >> 2;
    LAS unsigned char* L = F.lds;
    const float zf = zero_asm();
    bf16x8 qf[8];
    { const bf16* qp = U.Q + (size_t)(32 * qg + r) * 1024 + 128 * m + 8 * hh;
#pragma unroll
      for (int ks = 0; ks < 8; ++ks) qf[ks] = *(const GAS bf16x8*)(qp + 16 * ks);
#pragma unroll
      for (int ks = 0; ks < 8; ++ks) asm volatile("" : "+v"(qf[ks])); }
    const int r0 = tid >> 5, ch = tid & 31;
    v4u kr0, kr1, vr0, vr1;
    { const bf16* kp = U.K + (size_t)r0 * 1024 + ch * 8; const bf16* vp = U.V + (size_t)r0 * 1024 + ch * 8;
      kr0 = *(const GAS v4u*)kp; kr1 = *(const GAS v4u*)(kp + 16 * 1024); vr0 = *(const GAS v4u*)vp; vr1 = *(const GAS v4u*)(vp + 16 * 1024); }
    *(LAS v4u*)(L + AB_K0 + r0 * AB_KS + ch * 16) = kr0; *(LAS v4u*)(L + AB_K0 + (r0 + 16) * AB_KS + ch * 16) = kr1;
    *(LAS v4u*)(L + AB_V0 + r0 * AB_VS + ch * 16) = vr0; *(LAS v4u*)(L + AB_V0 + (r0 + 16) * AB_VS + ch * 16) = vr1;
    __syncthreads();
    const int nvis = (qg < 2) ? U.nvis_lo : U.nvis_hi;
    f32x16 O[8];
#pragma unroll
    for (int dt = 0; dt < 8; ++dt)
#pragma unroll
        for (int e = 0; e < 16; ++e) O[dt][e] = zf;
    float mrun = -INFINITY, lsum = zf;
    const int koff = r * AB_KS + (128 * m + 8 * hh) * 2;
    const int voff = (4 * hh + ((lane & 15) >> 2)) * AB_VS + (16 * ((lane >> 4) & 1) + 4 * (lane & 3)) * 2;
#pragma unroll 1
    for (int t = 0; t < U.ntiles; ++t) {
        const bool more = (t + 1) < U.ntiles;
        if (more) { const bf16* kp = U.K + (size_t)(32 * (t + 1) + r0) * 1024 + ch * 8; const bf16* vp = U.V + (size_t)(32 * (t + 1) + r0) * 1024 + ch * 8;
            kr0 = *(const GAS v4u*)kp; kr1 = *(const GAS v4u*)(kp + 16 * 1024); vr0 = *(const GAS v4u*)vp; vr1 = *(const GAS v4u*)(vp + 16 * 1024); }
        if (t < nvis) {
            const LAS unsigned char* Kb = L + AB_K0 + (t & 1) * AB_KB + koff; const LAS unsigned char* Vb = L + AB_V0 + (t & 1) * AB_VB + voff;
            f32x16 s;
#pragma unroll
            for (int e = 0; e < 16; ++e) s[e] = zf;
            bf16x8 kA = *(const LAS bf16x8*)(Kb), kB = *(const LAS bf16x8*)(Kb + 32);
#pragma unroll
            for (int ks = 0; ks < 8; ++ks) {
                if ((ks & 1) == 0) { s = MFMA32(kA, qf[ks], s); if (ks + 2 < 8) kA = *(const LAS bf16x8*)(Kb + 32 * (ks + 2)); }
                else { s = MFMA32(kB, qf[ks], s); if (ks + 2 < 8) kB = *(const LAS bf16x8*)(Kb + 32 * (ks + 2)); }
                __builtin_amdgcn_sched_barrier(0); }
#define AB_VF(idx, a0, a1) do { a0 = vtr(Vb + (16 * ((idx) >> 3)) * AB_VS + 64 * ((idx) & 7)); a1 = vtr(Vb + (16 * ((idx) >> 3) + 8) * AB_VS + 64 * ((idx) & 7)); } while (0)
            s16x4 vA0, vA1, vB0, vB1; AB_VF(0, vA0, vA1); AB_VF(1, vB0, vB1);
            float mx = fmaxf(fmaxf(fmaxf(s[0], s[1]), fmaxf(s[2], s[3])), fmaxf(fmaxf(s[4], s[5]), fmaxf(s[6], s[7])));
            mx = fmaxf(mx, fmaxf(fmaxf(fmaxf(s[8], s[9]), fmaxf(s[10], s[11])), fmaxf(fmaxf(s[12], s[13]), fmaxf(s[14], s[15]))));
            mx = swap32_max(mx);
            mx *= sc;
            if (!__all(mx <= mrun + 8.f)) {
                const float mn = fmaxf(mrun, mx), alpha = ex2(mrun - mn);
                lsum *= alpha;
#pragma unroll
                for (int dt = 0; dt < 8; ++dt)
#pragma unroll
                    for (int e = 0; e < 16; ++e) O[dt][e] *= alpha;
                mrun = mn;
            }
            float ps = 0.f;
#pragma unroll
            for (int e = 0; e < 16; ++e) { s[e] = ex2(__builtin_fmaf(s[e], sc, -mrun)); ps += s[e]; }
            lsum += ps;
            bf16x8 pf[2];
#pragma unroll
            for (int sp = 0; sp < 2; ++sp) { v4u pk; pk.x = pk2(s[8 * sp], s[8 * sp + 1]); pk.y = pk2(s[8 * sp + 2], s[8 * sp + 3]); pk.z = pk2(s[8 * sp + 4], s[8 * sp + 5]); pk.w = pk2(s[8 * sp + 6], s[8 * sp + 7]); pf[sp] = __builtin_bit_cast(bf16x8, pk); }
            __builtin_amdgcn_sched_barrier(0);
#pragma unroll
            for (int idx = 0; idx < 16; ++idx) {
                if ((idx & 1) == 0) { const bf16x8 vf = (bf16x8){vA0[0], vA0[1], vA0[2], vA0[3], vA1[0], vA1[1], vA1[2], vA1[3]};
                    O[idx & 7] = MFMA32(vf, pf[idx >> 3], O[idx & 7]); if (idx + 2 < 16) AB_VF(idx + 2, vA0, vA1); }
                else { const bf16x8 vf = (bf16x8){vB0[0], vB0[1], vB0[2], vB0[3], vB1[0], vB1[1], vB1[2], vB1[3]};
                    O[idx & 7] = MFMA32(vf, pf[idx >> 3], O[idx & 7]); if (idx + 2 < 16) AB_VF(idx + 2, vB0, vB1); }
                __builtin_amdgcn_sched_group_barrier(0x008, 1, 0); __builtin_amdgcn_sched_group_barrier(0x100, 2, 0);
            }
#undef AB_VF
        }
        if (more) { const int bo = ((t + 1) & 1);
            *(LAS v4u*)(L + AB_K0 + bo * AB_KB + r0 * AB_KS + ch * 16) = kr0; *(LAS v4u*)(L + AB_K0 + bo * AB_KB + (r0 + 16) * AB_KS + ch * 16) = kr1;
            *(LAS v4u*)(L + AB_V0 + bo * AB_VB + r0 * AB_VS + ch * 16) = vr0; *(LAS v4u*)(L + AB_V0 + bo * AB_VB + (r0 + 16) * AB_VS + ch * 16) = vr1; }
        __syncthreads();
    }
    const float l = swap32_sum(lsum);
    LAS unsigned char* X = L + qg * 32768 + lane * 16;
    if (m == 1) { const float sc2 = lam * __builtin_amdgcn_rcpf(l);
#pragma unroll
        for (int dt = 0; dt < 8; ++dt)
#pragma unroll
            for (int q4 = 0; q4 < 4; ++q4) *(LAS f32x4*)(X + dt * 4096 + q4 * 1024) = (f32x4){O[dt][4 * q4] * sc2, O[dt][4 * q4 + 1] * sc2, O[dt][4 * q4 + 2] * sc2, O[dt][4 * q4 + 3] * sc2}; }
    __syncthreads();
    float ss = 0.f;
    if (m == 0) { const float inv = __builtin_amdgcn_rcpf(l);
#pragma unroll
        for (int dt = 0; dt < 8; ++dt)
#pragma unroll
            for (int q4 = 0; q4 < 4; ++q4) { const f32x4 x2 = *(const LAS f32x4*)(X + dt * 4096 + q4 * 1024);
#pragma unroll
                for (int e = 0; e < 4; ++e) { const float o = O[dt][4 * q4 + e] * inv - x2[e]; O[dt][4 * q4 + e] = o; ss += o * o; } } }
    __syncthreads();
    if (m == 0) {
        ss = swap32_sum(ss);
        const float rstd = osc * __builtin_amdgcn_rsqf(ss * (1.f / 256.f) + SUBLN_EPS);
        LAS unsigned char* T = L + 70656 + qg * 16896;
#pragma unroll
        for (int dt = 0; dt < 8; ++dt)
#pragma unroll
            for (int q4 = 0; q4 < 4; ++q4) { const int d0 = 32 * dt + 8 * q4 + 4 * hh; const f32x4 sw = *(const GAS f32x4*)(subw + d0);
                v2u o; o.x = pk2(O[dt][4 * q4] * rstd * sw.x, O[dt][4 * q4 + 1] * rstd * sw.y); o.y = pk2(O[dt][4 * q4 + 2] * rstd * sw.z, O[dt][4 * q4 + 3] * rstd * sw.w);
                *(LAS v2u*)(T + r * 528 + d0 * 2) = o; }
        LDS_WAIT(); asm volatile("" ::: "memory");
        const int le = lane_id_asm(), rr = le >> 5, cc = (le & 31) * 8;
#pragma unroll
        for (int h8 = 0; h8 < 2; ++h8) {
        v4u gt[8];
#pragma unroll
        for (int i8 = 0; i8 < 8; ++i8) gt[i8] = *(const GAS v4u*)(U.Gt + (size_t)(32 * qg + 2 * (8 * h8 + i8) + rr) * 1024 + cc);
#pragma unroll
        for (int i8 = 0; i8 < 8; ++i8) { const int it = 8 * h8 + i8; const v4u y = *(const LAS v4u*)(T + (2 * it + rr) * 528 + cc * 2); const v4u g = gt[i8]; v4u o;
            o.x = pk2(bflo(y.x) * silu(bflo(g.x)), bfhi(y.x) * silu(bfhi(g.x))); o.y = pk2(bflo(y.y) * silu(bflo(g.y)), bfhi(y.y) * silu(bfhi(g.y)));
            o.z = pk2(bflo(y.z) * silu(bflo(g.z)), bfhi(y.z) * silu(bfhi(g.z))); o.w = pk2(bflo(y.w) * silu(bflo(g.w)), bfhi(y.w) * silu(bfhi(g.w)));
            *(GAS v4u*)(U.Yo + (size_t)(32 * qg + 2 * it + rr) * DM + cc) = o; }
        __builtin_amdgcn_sched_barrier(0); }
    }
}

__device__ __forceinline__ void attn_queue(Frame& F, int layer, unsigned* qcnt, const int x, unsigned* pbd, const unsigned nssd) {
    const float lambda_init = layer == 0 ? 0.2f : 0.35550906759096926f;
    float d1 = 0.f, d2 = 0.f;
    { const int i = F.lane * 2; const float* a = INP(18  ) + layer * 128; const float* b = INP(19  ) + layer * 128; const float* c = INP(20  ) + layer * 128; const float* d = INP(21  ) + layer * 128;
      d1 = a[i] * b[i] + a[i + 1] * b[i + 1]; d2 = c[i] * d[i] + c[i + 1] * d[i + 1]; }
    d1 = wave_sum(d1, F.lane); d2 = wave_sum(d2, F.lane);
    const int lam_s = __builtin_amdgcn_readfirstlane(__builtin_bit_cast(int, __expf(d1) - __expf(d2) + lambda_init));
    const float* subw = INP(22  ) + layer * 256;
    const float scd = 0.08838834764831845f * 1.4426950408889634f, scm = 0.0625f * 1.4426950408889634f;
    bool scan_seen = false;
    unsigned nxt = 0u; int slot = 0;
    if (F.tid == 0) { nxt = xb_add(qcnt, 1u); F.MISC[16] = nxt; }
#define AQ_TOP()    do { __syncthreads(); idx = __builtin_amdgcn_readfirstlane((int)F.MISC[16 + slot]); } while (0)
#define AQ_ISSUE()  do { if (F.tid == 0) nxt = xb_add(qcnt, 1u); } while (0)
#define AQ_BOTTOM() do { slot ^= 1; if (F.tid == 0) F.MISC[16 + slot] = nxt; } while (0)
    int idx; AQ_TOP();
#pragma unroll 1
    while (idx < 64) {
        AQ_ISSUE();
        { float lam = __builtin_bit_cast(float, lam_s); asm volatile("" : "+v"(lam));
          AttnUnit U; const int qt = 31 - (idx >> 1), bh = 2 * x + (idx & 1), b = bh >> 2, h = bh & 3; const size_t row = (size_t)b * SEQ + 128 * qt;
          U.Q = WSB(WS_QD) + row * 1024 + h * 256; U.K = WSB(WS_KD) + (size_t)b * SEQ * 1024 + h * 256; U.V = WSB(WS_VD) + (size_t)b * SEQ * 1024 + h * 256;
          U.Gt = WSB(WS_GD) + row * 1024 + h * 256; U.Yo = WSB(WS_Y) + row * DM + DSSM + h * 256; U.nq = 128; U.ntiles = 4 * qt + 4; U.nvis_lo = 4 * qt + 2; U.nvis_hi = 4 * qt + 4; U.lk = 1 << 30;
          attn_unit_b(F, U, lam, 1.f - lambda_init, subw, scd); }
        AQ_BOTTOM(); AQ_TOP();
    }
#pragma unroll 1
    while (idx < 144) {
        AQ_ISSUE();
        { float lam = __builtin_bit_cast(float, lam_s); asm volatile("" : "+v"(lam));
          AttnUnit U;
          if (idx < 72) {
            const int su = 8 * x + (idx - 64), b = su >> 2, h = su & 3; const size_t row = (size_t)MP + b * SL;
            U.Q = WSB(WS_QD) + row * 1024 + h * 256; U.K = WSB(WS_KS) + (size_t)b * LKSP * 1024 + h * 256; U.V = WSB(WS_VS) + (size_t)b * LKSP * 1024 + h * 256;
            U.Gt = WSB(WS_GD) + row * 1024 + h * 256; U.Yo = WSB(WS_Y) + row * DM + DSSM + h * 256; U.nq = SL; U.ntiles = (LKS + 31) / 32; U.nvis_lo = U.ntiles; U.nvis_hi = U.ntiles; U.lk = LKS;
            attn_unit<true>(F, U, lam, 1.f - lambda_init, subw, scd); }
          else {
            if (idx < 136) { const int uid = 64 * x + (idx - 72), b = uid >> 7, h = (uid >> 5) & 3, qt = uid & 31; const size_t row = (size_t)b * SEQ + 128 * qt;
                U.Q = WSB(WS_QM) + row * 1024 + h * 256; U.K = WSB(WS_MK) + (size_t)b * NMEM * 1024 + h * 256; U.V = WSB(WS_MV) + (size_t)b * NMEM * 1024 + h * 256;
                U.Gt = WSB(WS_GM) + row * 1024 + h * 256; U.Yo = WSB(WS_Y) + row * DM + DSSM + DDIFF + h * 256; U.nq = 128; }
            else { const int su = 8 * x + (idx - 136), b = su >> 2, h = su & 3; const size_t row = (size_t)MP + b * SL;
                U.Q = WSB(WS_QM) + row * 1024 + h * 256; U.K = WSB(WS_MKS) + (size_t)b * NMEM * 1024 + h * 256; U.V = WSB(WS_MVS) + (size_t)b * NMEM * 1024 + h * 256;
                U.Gt = WSB(WS_GM) + row * 1024 + h * 256; U.Yo = WSB(WS_Y) + row * DM + DSSM + DDIFF + h * 256; U.nq = SL; }
            U.ntiles = NMEM / 32; U.nvis_lo = U.ntiles; U.nvis_hi = U.ntiles; U.lk = 1 << 30;
            attn_unit<false>(F, U, 0.f, 1.f, subw, scm); } }
        AQ_BOTTOM(); AQ_TOP();
    }
#pragma unroll 1
    while (idx < 272) {
        AQ_ISSUE();
        {
            if (!scan_seen) { if (F.tid == 0) { unsigned sp = 0u; while (xb_ld(pbd) < nssd) { __builtin_amdgcn_s_sleep(4); if (++sp > (1u << 24)) break; } __builtin_amdgcn_fence(__ATOMIC_ACQUIRE, "agent"); asm volatile("s_waitcnt vmcnt(0)" ::: "memory"); }
                __syncthreads(); scan_seen = true; }
            const int u = (idx - 144) * 8 + x; ssd_pass_c_prompt(F, layer, u, u + 1, 1); }

        AQ_BOTTOM(); AQ_TOP();
    }
#undef AQ_TOP
#undef AQ_ISSUE
#undef AQ_BOTTOM
}

__device__ __forceinline__ void post_norm_phase(Frame& F, int layer) {
    const int gw = F.bx * NWAVES + F.wave, NGW = F.G * NWAVES, lane = F.lane;
    const float* wpost = INP(10  ) + layer * DM; const float* wpre = INP(9  ) + (layer + 1 < 2 ? layer + 1 : 1) * DM;
    const float* x_prompt = INP(0); const float* x_sample = INP(1);
#pragma unroll 1
    for (int m = gw; m < MT; m += NGW) {
        f32x4 o[16], x[16]; float ss = 0.f;
        if (m < MP) { const GAS v2u* op = (const GAS v2u*)(WSB(WS_HALL) + (size_t)m * DM) + lane;
#pragma unroll
            for (int j = 0; j < 16; ++j) { const v2u q = op[64 * j]; o[j] = (f32x4){bflo(q.x), bfhi(q.x), bflo(q.y), bfhi(q.y)}; } }
        else { const GAS f32x4* op = (const GAS f32x4*)(WSF(WS_O2P) + (size_t)(m - MP) * DM) + lane;
#pragma unroll
            for (int j = 0; j < 16; ++j) o[j] = op[64 * j];
#pragma unroll 1
            for (int sl = 1; sl < 16; ++sl) { op += (size_t)MS * DM / 4;
#pragma unroll
                for (int j = 0; j < 16; ++j) o[j] = o[j] + op[64 * j]; } }
        if (layer == 0) { const GAS f32x4* xr = (const GAS f32x4*)(m < MP ? x_prompt + (size_t)m * DM : x_sample + (size_t)(m - MP) * DM) + lane;
#pragma unroll
            for (int j = 0; j < 16; ++j) x[j] = xr[64 * j]; }
        else { const GAS v2u* xr = (const GAS v2u*)(WSB(WS_X1) + (size_t)m * DM) + lane;
#pragma unroll
            for (int j = 0; j < 16; ++j) { const v2u q = xr[64 * j]; x[j] = (f32x4){bflo(q.x), bfhi(q.x), bflo(q.y), bfhi(q.y)}; } }
#pragma unroll
        for (int j = 0; j < 16; ++j) ss += (o[j].x * o[j].x + o[j].y * o[j].y) + (o[j].z * o[j].z + o[j].w * o[j].w);
        const float rstd = 1.f / sqrtf(wave_sum(ss, lane) * (1.f / DM) + NORM_EPS);
        const GAS f32x4* wp = (const GAS f32x4*)wpost + lane;
        float s2 = 0.f;
#pragma unroll
        for (int j = 0; j < 16; ++j) { const f32x4 ww = wp[64 * j]; x[j] = x[j] + o[j] * rstd * ww; s2 += (x[j].x * x[j].x + x[j].y * x[j].y) + (x[j].z * x[j].z + x[j].w * x[j].w); }
        if (layer == 1) { GAS f32x4* xo = (GAS f32x4*)(F.out + (size_t)m * DM) + lane;
#pragma unroll
            for (int j = 0; j < 16; ++j) xo[64 * j] = x[j]; }
        else { GAS v2u* xo = (GAS v2u*)(WSB(WS_X1) + (size_t)m * DM) + lane;
#pragma unroll
            for (int j = 0; j < 16; ++j) { v2u q; q.x = pk2(x[j].x, x[j].y); q.y = pk2(x[j].z, x[j].w); xo[64 * j] = q; } }
        if (layer == 0) {
            const float r2 = 1.f / sqrtf(wave_sum(s2, lane) * (1.f / DM) + NORM_EPS);
            const GAS f32x4* wq = (const GAS f32x4*)wpre + lane; GAS v2u* ho = (GAS v2u*)(WSB(WS_HALL) + (size_t)m * DM) + lane;
#pragma unroll
            for (int j = 0; j < 16; ++j) { const f32x4 ww = wq[64 * j]; v2u q; q.x = pk2(x[j].x * r2 * ww.x, x[j].y * r2 * ww.y); q.y = pk2(x[j].z * r2 * ww.z, x[j].w * r2 * ww.w); ho[64 * j] = q; }
        }
    }
}

__device__ __forceinline__ void post_norm_sample(Frame& F, int layer) {
    const int lane = F.lane, w = F.wave; volatile LAS float* red = (volatile LAS float*)(F.lds + RING_OFF);
    const float* wpost = INP(10  ) + layer * DM; const float* x_sample = INP(1);
#pragma unroll 1
    for (int r = F.bx; r < MS; r += F.G) {
        const int m = MP + r, c0 = w * 512 + lane * 8;
        const GAS f32x4* op = (const GAS f32x4*)(WSF(WS_O2P) + (size_t)r * DM + c0);
        f32x4 a[16], b[16];
#pragma unroll
        for (int sl = 0; sl < 16; ++sl) { a[sl] = op[(size_t)sl * (MS * DM / 4)]; b[sl] = op[(size_t)sl * (MS * DM / 4) + 1]; }
        f32x4 o0 = a[0], o1 = b[0];
#pragma unroll
        for (int sl = 1; sl < 16; ++sl) { o0 = o0 + a[sl]; o1 = o1 + b[sl]; }
        float ss = ((o0.x * o0.x + o0.y * o0.y) + (o0.z * o0.z + o0.w * o0.w)) + ((o1.x * o1.x + o1.y * o1.y) + (o1.z * o1.z + o1.w * o1.w));
        ss = wave_sum(ss, lane); if (lane == 0) red[w] = ss; LDS_WAIT(); __syncthreads();
        const float tot = ((red[0] + red[1]) + (red[2] + red[3])) + ((red[4] + red[5]) + (red[6] + red[7]));
        const float rstd = 1.f / sqrtf(tot * (1.f / DM) + NORM_EPS);
        f32x4 x0, x1;
        if (layer == 0) { const GAS f32x4* xr = (const GAS f32x4*)(x_sample + (size_t)r * DM + c0); x0 = xr[0]; x1 = xr[1]; }
        else { const v4u q = *(const GAS v4u*)(WSB(WS_HALL) + (size_t)m * DM + c0); x0 = (f32x4){bflo(q.x), bfhi(q.x), bflo(q.y), bfhi(q.y)}; x1 = (f32x4){bflo(q.z), bfhi(q.z), bflo(q.w), bfhi(q.w)}; }
        const GAS f32x4* wp = (const GAS f32x4*)(wpost + c0);
        x0 = x0 + o0 * rstd * wp[0]; x1 = x1 + o1 * rstd * wp[1];
        if (layer == 1) { GAS f32x4* xo = (GAS f32x4*)(F.out + (size_t)m * DM + c0); xo[0] = x0; xo[1] = x1; }
        else {
            v4u q; q.x = pk2(x0.x, x0.y); q.y = pk2(x0.z, x0.w); q.z = pk2(x1.x, x1.y); q.w = pk2(x1.z, x1.w); *(GAS v4u*)(WSB(WS_HALL) + (size_t)m * DM + c0) = q;
            float s2 = ((x0.x * x0.x + x0.y * x0.y) + (x0.z * x0.z + x0.w * x0.w)) + ((x1.x * x1.x + x1.y * x1.y) + (x1.z * x1.z + x1.w * x1.w));
            s2 = wave_sum(s2, lane); if (lane == 0) red[8 + w] = s2; LDS_WAIT(); __syncthreads();
            if (F.tid == 0) { const float t2 = ((red[8] + red[9]) + (red[10] + red[11])) + ((red[12] + red[13]) + (red[14] + red[15])); WSF(WS_RS1)[m] = 1.f / sqrtf(t2 * (1.f / DM) + NORM_EPS); }
        }
        __syncthreads();
    }
    if (layer == 0) {
#pragma unroll 1
        for (int row = F.bx * 512 + F.tid; row < MP; row += F.G * 512) { const GAS f32x4* sp = (const GAS f32x4*)(WSF(WS_XS2) + (size_t)row * 16);
            const f32x4 a = sp[0], b = sp[1], c = sp[2], d = sp[3];
            const float t = (((a.x + a.y) + (a.z + a.w)) + ((b.x + b.y) + (b.z + b.w))) + (((c.x + c.y) + (c.z + c.w)) + ((d.x + d.y) + (d.z + d.w)));
            WSF(WS_RS1)[row] = 1.f / sqrtf(t * (1.f / DM) + NORM_EPS); }
    }
}

#define IN(k) (lo <= (k) && (k) < hi)
#define PHASE_FRAME(P) Frame P = F; asm volatile("" : "+s"(P.wave), "+s"(P.bx), "+s"(P.ws), "+s"(P.out)); P.lane = lane_id_asm(); P.tid = P.wave * 64 + P.lane
#define SEAM(k) do { if (IN(k) && IN((k) + 1)) { int w_ = F.wave; asm volatile("" : "+s"(w_)); xcd_barrier(bar, w_ == 0 && lane_id_asm() == 0); } else __syncthreads(); } while (0)
template <int layer>
__device__ __forceinline__ void layer_phases(Frame& F, const int lo, const int hi, const XcdBarrier& bar) {
        const int pb = 1 + 4 * layer;
        if (IN(pb + 0)) {
            { PHASE_FRAME(P);
            pg8::Gemm g{(const bf16*)(GAS bf16*)(P.ws + WS_HALL), (const bf16*)(GAS bf16*)(P.ws + WS_W1) + (size_t)layer * NW1 * DM, DM, DM};
            Sched1 S{P.G, P.bx, PM_MEM + 4 * layer};
            Epi1 E; E.ws = (unsigned char*)P.ws; E.out = (float*)P.out; E.dt_bias = inp_ptr(P, 14) + layer * NH; E.layer = layer; E.mem_pm0 = PM_MEM + 4 * layer;
            pg8::gemm_phase<Epi1, Sched1>(P.lds + RING_OFF, g, S, E, P.tid); }
            { PHASE_FRAME(P);
              constexpr int NU1 = 65 * 45 + 32; const int rounds = (NU1 + P.G - 1) / P.G, nshort = rounds * P.G - NU1;
              const int nr = nshort == 0 ? P.G : nshort, rank = nshort == 0 ? P.bx : P.bx - (P.G - nshort);
              if (rank >= 0) cache_convert(P, layer, rank, nr); }
            SEAM(pb + 0);
        }
        if (IN(pb + 1)) {
            constexpr int NSSD = 80;
            unsigned* const sbw = (unsigned*)(GAS unsigned*)(F.ws + WS_CTL) + CW_SB + layer * 2 * 64;
            { PHASE_FRAME(P); if (P.bx < NSSD) { P.G = NSSD; conv_phase(P, layer); } }
            if (F.bx < NSSD) { int w_ = F.wave; asm volatile("" : "+s"(w_)); sub_barrier(sbw, NSSD, w_ == 0 && lane_id_asm() == 0); }
            { PHASE_FRAME(P); if (P.bx < NSSD) { ssd_pass_a(P, layer, P.bx, NB * NCH * NG, NSSD); ssd_pass_a(P, layer, NB * NCH * NG + P.bx, NSSD_UNITS, NSSD); } }
            if (F.bx < NSSD) { int w_ = F.wave; asm volatile("" : "+s"(w_)); sub_barrier(sbw + 64, NSSD, w_ == 0 && lane_id_asm() == 0); }
            { PHASE_FRAME(P); if (P.bx < NSSD) { P.G = NSSD; ssd_pass_b(P, layer); } }
            if (F.bx < NSSD) { int w_ = F.wave; asm volatile("" : "+s"(w_)); asm volatile("s_waitcnt vmcnt(0)" ::: "memory"); __syncthreads();
                if (w_ == 0 && lane_id_asm() == 0) { __builtin_amdgcn_fence(__ATOMIC_RELEASE, "agent"); asm volatile("s_waitcnt vmcnt(0)" ::: "memory"); (void)xb_add((unsigned*)(GAS unsigned*)(F.ws + WS_CTL) + CW_PBD + layer * 64, 1u); } }
            { PHASE_FRAME(P); if (P.bx < NSSD) ssd_pass_c(P, layer, NB * NCH * NG + P.bx, NSSD_UNITS, NSSD); }
            { PHASE_FRAME(P); attn_queue(P, layer, (unsigned*)(GAS unsigned*)(P.ws + WS_CTL) + CW_Q + (layer * 8 + (P.bx & 7)) * 64, P.bx & 7, (unsigned*)(GAS unsigned*)(P.ws + WS_CTL) + CW_PBD + layer * 64, NSSD); }
            SEAM(pb + 1);
        }
        if (IN(pb + 2)) {
            { PHASE_FRAME(P); pg8::Gemm g{(const bf16*)(GAS bf16*)(P.ws + WS_Y), (const bf16*)(GAS bf16*)(P.ws + WS_WO) + (size_t)layer * DM * DM, DM, DM}; Sched2F S{P.G, P.bx};
                Epi2F<layer> E; E.ws = (unsigned char*)P.ws; E.out = (float*)P.out; E.wpost = inp_ptr(P, 10) + layer * DM; E.xres = layer == 0 ? inp_ptr(P, 0) : (const float*)(GAS float*)(P.ws + WS_HALL); E.xl = P.lds + RING_OFF + pg8::STAGE_BYTES;
                pg8::gemm_phase<Epi2F<layer>, Sched2F>(P.lds + RING_OFF, g, S, E, P.tid); }
            { PHASE_FRAME(P); pg8::Gemm g{(const bf16*)(GAS bf16*)(P.ws + WS_Y), (const bf16*)(GAS bf16*)(P.ws + WS_WO) + (size_t)layer * DM * DM, DM, 256}; Sched2S S{P.G, P.bx}; Epi2S E{(float*)(GAS float*)(P.ws + WS_O2P)}; pg8::gemm_phase<Epi2S, Sched2S>(P.lds + RING_OFF, g, S, E, P.tid); }
            SEAM(pb + 2);
        }
        if (IN(pb + 3)) { { PHASE_FRAME(P); post_norm_sample(P, layer); } if (layer == 0) SEAM(pb + 3); }
    }
constexpr int NPHASES = 9;
struct Args { const float* in[26]; float* out; unsigned char* ws; int ph_lo, ph_hi; };
static_assert(sizeof(Args) == 26 * 8 + 8 + 8 + 8, "Args has no padding");
__global__ void __launch_bounds__(NWAVES * 64, 2) mk_fwd(Args args) {
    extern __shared__ __attribute__((aligned(16))) unsigned char lds[];
    Frame F;
    F.lds = (LAS unsigned char*)lds;
    F.MISC = (volatile LAS unsigned*)(F.lds + MISC_OFF);
    F.tid = 0; F.lane = 0; F.wave = __builtin_amdgcn_readfirstlane(threadIdx.x >> 6);
    F.G = gridDim.x; F.bx = blockIdx.x;
    F.ws = (GAS unsigned char*)args.ws; F.out = (GAS float*)args.out;
    { const int t0 = threadIdx.x;
    for (int u = t0; u < (LDS_BYTES - LDSCTL_OFF) / 4; u += NWAVES * 64) ((LAS unsigned*)(F.lds + LDSCTL_OFF))[u] = 0u;
    __syncthreads();
    F.tid = t0; }
    if (F.tid < 26) { const unsigned long long p = ((const __attribute__((address_space(4))) unsigned long long*)__builtin_amdgcn_kernarg_segment_ptr())[F.tid];
        ((LAS unsigned*)(F.lds + INP_OFF))[2 * F.tid] = (unsigned)p; ((LAS unsigned*)(F.lds + INP_OFF))[2 * F.tid + 1] = (unsigned)(p >> 32); }
    __syncthreads();
    F.tid = 0;
    const int lo = args.ph_lo, hi = args.ph_hi;
    XcdBarrier bar; bar.bar = (unsigned*)(GAS unsigned*)(F.ws + WS_CTL) + CW_BAR; bar.x = 0; bar.st = nullptr;
    if (hi - lo > 1) { bar.x = xb_xcc_id(); bar.st = F.MISC + 8; if (F.wave == 0 && lane_id_asm() == 0) (void)xb_add(&bar.bar[XB_XCNT(bar.x)], 1u); }

    if (IN(0)) {
#if !(MK_SKIP & 1)
 { PHASE_FRAME(P); p0_prologue(P); }
#if (MK_DUP & 1)
 __syncthreads();
 { PHASE_FRAME(P); p0_prologue(P); }
#endif
#endif
 SEAM(0); }
    layer_phases<0>(F, lo, hi, bar);
    layer_phases<1>(F, lo, hi, bar);
#undef IN
#undef SEAM
}

extern "C" void kernel_launch(void* const* d_in, const int* in_sizes, int n_in, void* d_out, int out_size, void* d_ws, size_t ws_size, hipStream_t stream) {
    static int grid = 0;
    if (grid == 0) {
        if (n_in != 26 || (size_t)out_size != O_END || ws_size < WS_END) { fprintf(stderr, "kernel_launch: unexpected problem (n_in %d, out %d, ws %zu; need ws >= %zu); nothing launched\n", n_in, out_size, ws_size, (size_t)WS_END); grid = -1; return; }
        int dev = 0, cus = 0, per_cu = 0;
        if (hipGetDevice(&dev) != hipSuccess || hipDeviceGetAttribute(&cus, hipDeviceAttributeMultiprocessorCount, dev) != hipSuccess) { grid = -1; return; }
        if (hipFuncSetAttribute((const void*)mk_fwd, hipFuncAttributeMaxDynamicSharedMemorySize, LDS_BYTES) != hipSuccess) { fprintf(stderr, "kernel_launch: hipFuncSetAttribute failed\n"); grid = -1; return; }
        if (hipOccupancyMaxActiveBlocksPerMultiprocessor(&per_cu, (const void*)mk_fwd, NWAVES * 64, LDS_BYTES) != hipSuccess || per_cu < 1)
            fprintf(stderr, "kernel_launch: note: occupancy query reports %d workgroups per CU\n", per_cu);
        (void)hipGetLastError();
        grid = cus;
        if (grid != 256) { fprintf(stderr, "kernel_launch: built for a 256-CU device (the fused GEMM2 epilogue exchanges row statistics between the 256 workgroups of a round); found %d CUs; nothing launched\n", cus); grid = -1; return; }
    }
    if (grid < 0) return;
    if (hipMemsetAsync((char*)d_ws + WS_CTL, 0, CTL_ZERO_BYTES, stream) != hipSuccess) return;
    Args a{};
    for (int i = 0; i < 26; ++i) a.in[i] = (const float*)d_in[i];
    a.out = (float*)d_out; a.ws = (unsigned char*)d_ws;
#if MK_ONE_LAUNCH
    a.ph_lo = 0; a.ph_hi = NPHASES;
    hipLaunchKernelGGL(mk_fwd, dim3(grid), dim3(NWAVES * 64), LDS_BYTES, stream, a);
#else
    for (int k = 0; k < NPHASES; ++k) { a.ph_lo = k; a.ph_hi = k + 1; hipLaunchKernelGGL(mk_fwd, dim3(grid), dim3(NWAVES * 64), LDS_BYTES, stream, a); }
#endif
}
```

```cpp
#include <hip/hip_runtime.h>
#include <cstdio>
#include <cstdint>

#ifndef MK_ONE_LAUNCH
#define MK_ONE_LAUNCH 1
#endif
#ifndef MK_SKIP
#define MK_SKIP 0
#endif
#ifndef MK_PROBE_LD
#define MK_PROBE_LD 0
#endif
#ifndef MK_DUP
#define MK_DUP 0
#endif
#ifndef MK_DUPA
#define MK_DUPA 0
#endif

namespace pg8 {
#define PG8_LAS __attribute__((address_space(3)))
typedef unsigned short bf16_t;
typedef short bf16x8 __attribute__((ext_vector_type(8)));
typedef float f32x4 __attribute__((ext_vector_type(4)));
typedef unsigned u32x4 __attribute__((ext_vector_type(4)));
constexpr int BM = 256, BK = 64, HALF = 128, HTB = HALF * BK * 2  , STAGE_BYTES = 8 * HTB, NXCD = 8, WGM = 8;

__host__ __device__ __forceinline__ int lds_byte(int r, int c) { return (r >> 3) * 1024 + (r & 7) * 128 + ((((c >> 3) ^ r) & 7) << 4) + (c & 7) * 2; }
__host__ __device__ __forceinline__ void stage_rc(int b, int& R, int& C) { const int rr = (b >> 7) & 7; R = (b >> 10) * 8 + rr; C = (((b >> 4) ^ rr) & 7) << 3; }
__host__ __device__ __forceinline__ int perm32(int rho) { const int n = rho >> 4, i = rho & 15; return 8 * (i >> 2) + 4 * n + (i & 3); }

struct Unit { int pm, pn, kb; };
struct Gemm { const bf16_t* A; const bf16_t* Bt; int ld, K; };

__host__ __device__ __forceinline__ void rect_tile(int wgid, int nM, int nN, int& pm, int& pn) {
    const int nwg = nM * nN;
    { const int q = nwg / NXCD, r = nwg % NXCD, xcd = wgid % NXCD, off = wgid / NXCD; wgid = (xcd < r ? xcd * (q + 1) : r * (q + 1) + (xcd - r) * q) + off; }
    const int nig = WGM * nN, gid = wgid / nig, fm = gid * WGM, gsz = (nM - fm) < WGM ? (nM - fm) : WGM;
    pm = fm + ((wgid % nig) % gsz); pn = (wgid % nig) / gsz;
}

template <class Epi, class Sched>
__device__ __forceinline__ void gemm_phase(PG8_LAS unsigned char* lds, const Gemm g, const Sched& S, const Epi& E, const int tid) {
    const int wid = __builtin_amdgcn_readfirstlane(tid >> 6), lane = tid & 63, wr = wid >> 2, wc = wid & 3, fr = lane & 15, fq = lane >> 4;
    const int ld = g.ld, nt = g.K / BK;
    unsigned voffA[2], voffB[2];
#pragma unroll
    for (int i = 0; i < 2; ++i) { int R, C; stage_rc(tid * 16 + i * 8192, R, C); const int Rb = Epi::PERM ? ((R & ~31) + perm32(R & 31)) : R;
        voffA[i] = (unsigned)(R * ld + C) * 2u; voffB[i] = (unsigned)(Rb * ld + C) * 2u; }
    const size_t kstep = (size_t)(BK * 2);
    const size_t hstep = (size_t)HALF * ld * 2;
    const size_t tstep = 2 * hstep;
    const unsigned ldsw = (unsigned)wid * 1024u;
    const int aoff = lds_byte(wr * 64 + fr, fq * 8), boff = lds_byte(wc * 32 + fr, fq * 8);
#define PG8_SA(b, h) (((b) * 2 + (h)) * HTB)
#define PG8_SB(b, h) ((4 + (b) * 2 + (h)) * HTB)
#define PG8_STAGE(bufoff, gbase, voff) do { _Pragma("unroll") for (int _i = 0; _i < 2; ++_i) { unsigned _vo = (voff)[_i]; asm volatile("" : "+v"(_vo));     \
        __builtin_amdgcn_global_load_lds((const unsigned*)((const char*)(gbase) + _vo), (PG8_LAS unsigned*)(lds + (bufoff) + ldsw + _i * 8192), 16, 0, 0); } } while (0)
#define PG8_LDA(dst, b, h) do { int a1_ = aoff ^ 64; asm volatile("" : "+v"(a1_));     \
        _Pragma("unroll") for (int m = 0; m < 4; ++m) { dst[m][0] = *(const PG8_LAS bf16x8*)(lds + PG8_SA(b, h) + aoff + m * 2048); dst[m][1] = *(const PG8_LAS bf16x8*)(lds + PG8_SA(b, h) + a1_ + m * 2048); } } while (0)
#define PG8_LDB(dst, b, h) do { int b1_ = boff ^ 64; asm volatile("" : "+v"(b1_)); \
        _Pragma("unroll") for (int n = 0; n < 2; ++n) { dst[n][0] = *(const PG8_LAS bf16x8*)(lds + PG8_SB(b, h) + boff + n * 2048); dst[n][1] = *(const PG8_LAS bf16x8*)(lds + PG8_SB(b, h) + b1_ + n * 2048); } } while (0)
#define PG8_MMA(ai, bj, At, Bt) do { __builtin_amdgcn_s_setprio(1); _Pragma("unroll") for (int m = 0; m < 4; ++m) _Pragma("unroll") for (int n = 0; n < 2; ++n) _Pragma("unroll") for (int k = 0; k < 2; ++k) \
        acc[ai][bj][m][n] = __builtin_amdgcn_mfma_f32_16x16x32_bf16(Bt[n][k], At[m][k], acc[ai][bj][m][n], 0, 0, 0); __builtin_amdgcn_s_setprio(0); } while (0)
#define PG8_WAIT_V(n) asm volatile("s_waitcnt vmcnt(" #n ")" ::: "memory")
#define PG8_WAIT_L(n) asm volatile("s_waitcnt lgkmcnt(" #n ")" ::: "memory")
#define PG8_BAR __builtin_amdgcn_s_barrier()
#define PG8_SCHED __builtin_amdgcn_sched_barrier(0)
    Unit cur, nxt; int ui = 0;
    if (!S.next(0, cur)) return;
    float zf; asm volatile("v_mov_b32 %0, 0" : "=v"(zf));
    f32x4 acc[2][2][4][2];
#pragma unroll
    for (int a = 0; a < 2; ++a)
#pragma unroll
        for (int b = 0; b < 2; ++b)
#pragma unroll
            for (int m = 0; m < 4; ++m)
#pragma unroll
                for (int n = 0; n < 2; ++n) acc[a][b][m][n] = (f32x4){zf, zf, zf, zf};
    bf16x8 At[4][2], B0[2][2], B1[2][2];
    const char* cA = (const char*)g.A + (size_t)cur.pm * tstep + cur.kb; const char* cB = (const char*)g.Bt + (size_t)cur.pn * tstep + cur.kb;
    PG8_STAGE(PG8_SB(0, 0), cB, voffB); PG8_STAGE(PG8_SB(0, 1), cB + hstep, voffB); PG8_STAGE(PG8_SA(0, 0), cA, voffA); PG8_STAGE(PG8_SA(0, 1), cA + hstep, voffA);
    if (wr == 1) PG8_BAR;
    PG8_WAIT_V(2); PG8_BAR;
    PG8_STAGE(PG8_SB(1, 0), cB + kstep, voffB); PG8_STAGE(PG8_SA(1, 0), cA + kstep, voffA); PG8_STAGE(PG8_SB(1, 1), cB + hstep + kstep, voffB);
    PG8_WAIT_V(6); PG8_BAR;
    for (;;) {
        const bool has_next = S.next(ui + 1, nxt);
        const char* nA = has_next ? (const char*)g.A + (size_t)nxt.pm * tstep + nxt.kb : cA; const char* nB = has_next ? (const char*)g.Bt + (size_t)nxt.pn * tstep + nxt.kb : cB;
        for (int t = 0; t < nt; t += 2) {
            const bool last = (t == nt - 2);
            const char* a1 = cA + (size_t)(t + 1) * kstep;
            const char* a2 = last ? nA : cA + (size_t)(t + 2) * kstep; const char* b2 = last ? nB : cB + (size_t)(t + 2) * kstep;
            const char* a3 = a2 + kstep; const char* b3 = b2 + kstep;
            PG8_LDB(B0, 0, 0); PG8_LDB(B1, 0, 1); PG8_SCHED; PG8_LDA(At, 0, 0); PG8_STAGE(PG8_SA(1, 1), a1 + hstep, voffA);
            PG8_WAIT_V(8); PG8_WAIT_L(0); PG8_BAR; PG8_MMA(0, 0, At, B0); PG8_MMA(0, 1, At, B1); PG8_BAR; PG8_SCHED;
            PG8_LDA(At, 0, 1); PG8_STAGE(PG8_SB(0, 0), b2, voffB); PG8_STAGE(PG8_SB(0, 1), b2 + hstep, voffB); PG8_STAGE(PG8_SA(0, 0), a2, voffA);
            PG8_WAIT_V(8); PG8_WAIT_L(0); PG8_BAR; PG8_MMA(1, 0, At, B0); PG8_MMA(1, 1, At, B1); PG8_BAR; PG8_SCHED;
            PG8_LDB(B0, 1, 0); PG8_LDB(B1, 1, 1); PG8_SCHED; PG8_LDA(At, 1, 0); PG8_STAGE(PG8_SA(0, 1), a2 + hstep, voffA);
            PG8_WAIT_V(8); PG8_WAIT_L(0); PG8_BAR; PG8_MMA(0, 0, At, B0); PG8_MMA(0, 1, At, B1); PG8_BAR; PG8_SCHED;
            PG8_LDA(At, 1, 1); PG8_STAGE(PG8_SB(1, 0), b3, voffB); PG8_STAGE(PG8_SB(1, 1), b3 + hstep, voffB); PG8_STAGE(PG8_SA(1, 0), a3, voffA);
            PG8_WAIT_V(8); PG8_WAIT_L(0); PG8_BAR; PG8_MMA(1, 0, At, B0); PG8_MMA(1, 1, At, B1); PG8_BAR; PG8_SCHED;
        }
        if (wr == 0) PG8_BAR;
        { int l_; asm volatile("v_mbcnt_lo_u32_b32 %0, -1, 0\n\tv_mbcnt_hi_u32_b32 %0, -1, %0" : "=v"(l_)); const int fr_ = l_ & 15, fq_ = l_ >> 4;
          Unit cu = cur; asm volatile("" : "+s"(cu.pm), "+s"(cu.pn), "+s"(cu.kb));
          E(acc, cu, wr, wc, fr_, fq_); }
        if (!has_next) break;
#pragma unroll
        for (int a = 0; a < 2; ++a)
#pragma unroll
            for (int b = 0; b < 2; ++b)
#pragma unroll
                for (int m = 0; m < 4; ++m)
#pragma unroll
                    for (int n = 0; n < 2; ++n) acc[a][b][m][n] = (f32x4){zf, zf, zf, zf};
        cur = nxt; cA = nA; cB = nB; ++ui;
        if (wr == 1) PG8_BAR;
    }
    PG8_WAIT_V(0);
    PG8_BAR;
#undef PG8_SA
#undef PG8_SB
#undef PG8_STAGE
#undef PG8_LDA
#undef PG8_LDB
#undef PG8_MMA
#undef PG8_WAIT_V
#undef PG8_WAIT_L
#undef PG8_BAR
#undef PG8_SCHED
}
}

constexpr int DM = 4096, SEQ = 4096, NB = 4, MP = NB * SEQ, SB = 16, SL = 16, MS = SB * SL, MT = MP + MS;
constexpr int MTP = MT + 128;
constexpr int NCK = MP / 64 + SB;
constexpr int PAST = 1024, LKS = PAST + SL, LKSP = 1088;
constexpr int DSSM = 2048, NH = 32, HDIM = 64, NG = 4, DST = 128, DCONV = 3072, GB = NG * DST;
constexpr int DDIFF = 1024, DMEM = 1024, NMEM = 256, NMROWS = NB * NMEM;
constexpr int DIN = 11296, N1P = 11520, NMKV = 2048, NW1 = N1P + NMKV;
constexpr int NCH = SEQ / 64;
constexpr float NORM_EPS = 1e-6f, SUBLN_EPS = 1e-5f;
constexpr int T_Z = 0, T_XBC = 8, T_QD = 20, T_KD = 24, T_VD = 28, T_GD = 32, T_QM = 36, T_GM = 40, T_DT = 44, T_MEM = 45;
constexpr int PM_S = 64, PM_MEM = 65;

constexpr size_t O_YP = 0, O_YS = O_YP + (size_t)MP * DM, O_PCONV = O_YS + (size_t)MS * DM, O_PSSM = O_PCONV + 2ull * NB * 3 * DCONV,
    O_PK = O_PSSM + 2ull * NB * NH * HDIM * DST, O_PV = O_PK + 2ull * MP * 1024, O_PMK = O_PV + 2ull * MP * 1024, O_PMV = O_PMK + 2ull * NMROWS * 1024,
    O_SCONV = O_PMV + 2ull * NMROWS * 1024, O_SSSM = O_SCONV + 2ull * SB * 3 * DCONV, O_SK = O_SSSM + 2ull * SB * NH * HDIM * DST, O_SV = O_SK + 2ull * MS * 1024,
    O_END = O_SV + 2ull * MS * 1024;
static_assert(O_END == 151363584ull, "output size");

constexpr size_t MiB = 1u << 20;
constexpr size_t al(size_t x) { return (x + 4095) & ~(size_t)4095; }
constexpr size_t WS_CTL = 0, CTL_ZERO_BYTES = 1 * MiB;
constexpr size_t WS_W1 = 1 * MiB;
constexpr size_t W1_LAYER = (size_t)NW1 * DM * 2;
constexpr size_t WS_WO = al(WS_W1 + 2 * W1_LAYER);
constexpr size_t WO_LAYER = (size_t)DM * DM * 2;
constexpr size_t WS_HALL = al(WS_WO + 2 * WO_LAYER);
constexpr size_t WS_Z = al(WS_HALL + (size_t)(MT + 2 * NMROWS) * DM * 2);
constexpr size_t WS_XBC = al(WS_Z + (size_t)MT * DSSM * 2);
constexpr size_t WS_QD = al(WS_XBC + (size_t)MT * DCONV * 2);
constexpr size_t WS_GD = al(WS_QD + (size_t)MT * 1024 * 2);
constexpr size_t WS_QM = al(WS_GD + (size_t)MT * 1024 * 2);
constexpr size_t WS_GM = al(WS_QM + (size_t)MT * 1024 * 2);
constexpr size_t WS_KD = al(WS_GM + (size_t)MT * 1024 * 2);
constexpr size_t WS_VD = al(WS_KD + (size_t)MP * 1024 * 2);
constexpr size_t WS_KS = al(WS_VD + (size_t)MP * 1024 * 2);
constexpr size_t WS_VS = al(WS_KS + (size_t)SB * LKSP * 1024 * 2);
constexpr size_t WS_MK = al(WS_VS + (size_t)SB * LKSP * 1024 * 2);
constexpr size_t WS_MV = al(WS_MK + (size_t)NMROWS * 1024 * 2);
constexpr size_t WS_MKS = al(WS_MV + (size_t)NMROWS * 1024 * 2);
constexpr size_t WS_MVS = al(WS_MKS + (size_t)SB * NMEM * 1024 * 2);
constexpr size_t WS_DT = al(WS_MVS + (size_t)SB * NMEM * 1024 * 2);
constexpr size_t WS_DC = al(WS_DT + (size_t)MTP * 32 * 4);
constexpr size_t WS_XT = al(WS_DC + (size_t)NB * NCH * NH * 4);
constexpr size_t WS_BT = al(WS_XT + (size_t)NCK * DSSM * 64 * 2);
constexpr size_t WS_BTOK = al(WS_BT + (size_t)NCK * GB * 64 * 2);
constexpr size_t WS_CTOK = al(WS_BTOK + (size_t)MTP * GB * 2);
constexpr size_t WS_ST = al(WS_CTOK + (size_t)MTP * GB * 2);
constexpr size_t WS_Y = al(WS_ST + (size_t)NB * NCH * NH * 8192 * 2);
constexpr size_t WS_O2P = WS_XBC;
static_assert(16ull * MS * DM * 4 <= (size_t)MT * DCONV * 2, "O2P fits inside XBC");
constexpr size_t WS_CHK = al(WS_Y + (size_t)MT * DM * 2);
constexpr size_t WS_X1 = al(WS_CHK + 1 * MiB);
constexpr size_t WS_XS1 = WS_CHK;
constexpr size_t WS_XS2 = al(WS_X1 + (size_t)MT * DM * 2);
constexpr size_t WS_RS1 = WS_XS2 + 1 * MiB;
constexpr size_t WS_END = WS_RS1 + 1 * MiB;
static_assert(WS_END <= 1480589312ull, "workspace map must fit 4 x the largest input");
constexpr int CW_TMO = 0, CW_CODE = 1;
constexpr int CW_BAR = 4096;
constexpr int CW_SB = 32768;
constexpr int CW_PBD = 34816;
constexpr int CW_Q = 36864;
constexpr int CW_XC = 16384;

constexpr int RING_OFF = 0, RING_BYTES = 155648;
constexpr int LDSCTL_OFF = RING_BYTES, MISC_OFF = LDSCTL_OFF + 320;
constexpr int LDS_BYTES = 159744;
static_assert(MISC_OFF + 128 <= LDS_BYTES, "LDS map");
constexpr int NWAVES = 8;

#define GAS __attribute__((address_space(1)))
#define LAS __attribute__((address_space(3)))
typedef unsigned short bf16;
typedef unsigned v4u __attribute__((ext_vector_type(4)));
typedef unsigned v2u __attribute__((ext_vector_type(2)));
typedef float f32x4 __attribute__((ext_vector_type(4)));
typedef float f32x16 __attribute__((ext_vector_type(16)));
typedef short bf16x8 __attribute__((ext_vector_type(8)));
typedef short s16x4 __attribute__((ext_vector_type(4)));
typedef GAS unsigned gu32;
#define RLX_AGENT __ATOMIC_RELAXED, __HIP_MEMORY_SCOPE_AGENT
#define LDS_WAIT() asm volatile("s_waitcnt lgkmcnt(0)" ::: "memory")
#define VM_WAIT() asm volatile("s_waitcnt vmcnt(0)" ::: "memory")
__device__ __forceinline__ unsigned f2bf(float f) { unsigned u = __builtin_bit_cast(unsigned, f); return (u + 0x7fffu + ((u >> 16) & 1u)) >> 16; }
typedef float f32x2_t __attribute__((ext_vector_type(2)));
typedef __bf16 bf16x2_t __attribute__((ext_vector_type(2)));
__device__ __forceinline__ unsigned pk2(float lo, float hi) { const f32x2_t v = {lo, hi}; const bf16x2_t b = __builtin_convertvector(v, bf16x2_t); return __builtin_bit_cast(unsigned, b); }
__device__ __forceinline__ float bflo(unsigned u) { return __builtin_bit_cast(float, u << 16); }
__device__ __forceinline__ float bfhi(unsigned u) { return __builtin_bit_cast(float, u & 0xffff0000u); }
__device__ __forceinline__ float bf2f(bf16 h) { return __builtin_bit_cast(float, (unsigned)h << 16); }
__device__ __forceinline__ float ex2(float x) { return __builtin_amdgcn_exp2f(x); }
__device__ __forceinline__ float fexp(float x) { return __builtin_amdgcn_exp2f(x * 1.4426950408889634f); }
__device__ __forceinline__ float silu(float x) { return x * __builtin_amdgcn_rcpf(1.f + fexp(-x)); }
__device__ __forceinline__ float softplus(float x) { return x > 20.f ? x : log1pf(__expf(x)); }
__device__ __forceinline__ float shx(float v, int lane, int m) { return __builtin_bit_cast(float, __builtin_amdgcn_ds_bpermute((lane ^ m) << 2, __builtin_bit_cast(int, v))); }
__device__ __forceinline__ float shl_from(float v, int src_lane) { return __builtin_bit_cast(float, __builtin_amdgcn_ds_bpermute(src_lane << 2, __builtin_bit_cast(int, v))); }
__device__ __forceinline__ float wave_sum(float v, int lane) {
#pragma unroll
    for (int o = 1; o < 64; o <<= 1) v += shx(v, lane, o);
    return v;
}

#define XB_TMO      128
#define XB_XCNT(j)  (256  + 64 * (j))
#define XB_XSUB(j)  (1280 + 64 * (j))
#define XB_XGEN(j)  (2304 + 64 * (j))
#define XB_TOP      3328
#define XB_TOPGEN   3392
#define XCD_BAR_WORDS 3456
#define XB_SPIN_CAP (1u << 18)
__device__ __forceinline__ unsigned xb_ld(unsigned* p)              { return __hip_atomic_load(p, __ATOMIC_RELAXED, __HIP_MEMORY_SCOPE_AGENT); }
__device__ __forceinline__ unsigned xb_add(unsigned* p, unsigned v) { return __hip_atomic_fetch_add(p, v, __ATOMIC_RELAXED, __HIP_MEMORY_SCOPE_AGENT); }
__device__ __forceinline__ unsigned xb_xcc_id() { return (unsigned)__builtin_amdgcn_s_getreg((3 << 11) | 20) & 0xFu; }
#define XB_SPIN(cond, bar) do { unsigned _sp = 0; while (cond) { __builtin_amdgcn_s_sleep(1); \
    if ((++_sp & 255u) == 0u) { if (xb_ld(&(bar)[XB_TMO])) break; if (_sp > XB_SPIN_CAP) { atomicAdd(&(bar)[XB_TMO], 1u); break; } } } } while (0)
struct XcdBarrier { unsigned* bar; unsigned x; volatile LAS unsigned* st; };
__device__ __forceinline__ XcdBarrier xcd_barrier_post(unsigned* bar, volatile LAS unsigned* st) {
    XcdBarrier b; b.bar = bar; b.x = xb_xcc_id(); b.st = st;
    if (threadIdx.x == 0) (void)xb_add(&bar[XB_XCNT(b.x)], 1u);
    return b;
}
__device__ __forceinline__ void xcd_barrier_complete(unsigned* bar, unsigned x, unsigned& nloc, unsigned& nx) {
    const unsigned G = gridDim.x * gridDim.y * gridDim.z;
    unsigned sum, cnt, mine, sp = 0u;
    for (;;) {
        sum = 0u; cnt = 0u; mine = 0u;
#pragma unroll
        for (unsigned j = 0; j < 16; ++j) { const unsigned c = xb_ld(&bar[XB_XCNT(j)]); sum += c; cnt += (c > 0u) ? 1u : 0u; mine = (j == x) ? c : mine; }
        if (sum == G) break;
        __builtin_amdgcn_s_sleep(1);
        if ((++sp & 255u) == 0u) { if (xb_ld(&bar[XB_TMO])) break; if (sp > XB_SPIN_CAP) { atomicAdd(&bar[XB_TMO], 1u); break; } }
    }
    nloc = mine > 0u ? mine : 1u; nx = cnt > 0u ? cnt : 1u;
}
__device__ __forceinline__ void xcd_barrier(const XcdBarrier& b, const bool leader  ) {
    asm volatile("s_waitcnt vmcnt(0)" ::: "memory");
    __syncthreads();
    if (leader) {
        unsigned* bar = b.bar;
        __builtin_amdgcn_s_waitcnt(0);
        unsigned nloc = b.st[0], nx = b.st[1];
        if (nloc == 0u) { xcd_barrier_complete(bar, b.x, nloc, nx); b.st[0] = nloc; b.st[1] = nx; }
        const unsigned old = xb_add(&bar[XB_XSUB(b.x)], 1u);
        const unsigned gen = old / nloc;
        if (old + 1u == (gen + 1u) * nloc) {
            __builtin_amdgcn_fence(__ATOMIC_RELEASE, "agent");
            asm volatile("s_waitcnt vmcnt(0)" ::: "memory");
            const unsigned og = xb_add(&bar[XB_TOP], 1u);
            const unsigned tg = og / nx;
            if (og + 1u == (tg + 1u) * nx) xb_add(&bar[XB_TOPGEN], 1u);
            else XB_SPIN(xb_ld(&bar[XB_TOPGEN]) == tg, bar);
            __builtin_amdgcn_fence(__ATOMIC_ACQUIRE, "agent");
            xb_add(&bar[XB_XGEN(b.x)], 1u);
            asm volatile("s_waitcnt vmcnt(0)" ::: "memory");
        } else {
            XB_SPIN(xb_ld(&bar[XB_XGEN(b.x)]) == gen, bar);
            __builtin_amdgcn_fence(__ATOMIC_ACQUIRE, "agent");
            asm volatile("s_waitcnt vmcnt(0)" ::: "memory");
        }
    }
    __syncthreads();
}

__device__ __forceinline__ void sub_barrier(unsigned* cnt, unsigned n, const bool leader) {
    asm volatile("s_waitcnt vmcnt(0)" ::: "memory");
    __syncthreads();
    if (leader) {
        __builtin_amdgcn_fence(__ATOMIC_RELEASE, "agent");
        asm volatile("s_waitcnt vmcnt(0)" ::: "memory");
        (void)xb_add(cnt, 1u);
        unsigned sp = 0u;
        while (xb_ld(cnt) < n) { __builtin_amdgcn_s_sleep(2); if (++sp > (1u << 24)) break; }
        __builtin_amdgcn_fence(__ATOMIC_ACQUIRE, "agent");
        asm volatile("s_waitcnt vmcnt(0)" ::: "memory");
    }
    __syncthreads();
}

struct Frame {
    LAS unsigned char* lds;
    volatile LAS unsigned* MISC;
    GAS unsigned char* ws; GAS float* out;
    int tid, lane, wave, G, bx;
};
__device__ __forceinline__ float zero_asm() { float z; asm volatile("v_mov_b32 %0, 0" : "=v"(z)); return z; }
__device__ __forceinline__ int lane_id_asm() { int l; asm volatile("v_mbcnt_lo_u32_b32 %0, -1, 0\n\tv_mbcnt_hi_u32_b32 %0, -1, %0" : "=v"(l)); return l; }
#define WSB(off) ((bf16*)(GAS bf16*)(F.ws + (off)))
#define WSF(off) ((float*)(GAS float*)(F.ws + (off)))
constexpr int INP_OFF = LDSCTL_OFF;
__device__ __forceinline__ const float* inp_ptr(const Frame& F, int i) {
    const volatile LAS unsigned* p = (const volatile LAS unsigned*)(F.lds + INP_OFF) + 2 * i;
    const unsigned lo = __builtin_amdgcn_readfirstlane(p[0]), hi = __builtin_amdgcn_readfirstlane(p[1]);
    return (const float*)(const GAS float*)(((unsigned long long)hi << 32) | lo);
}
#define INP(i) inp_ptr(F, (i))

__device__ __forceinline__ void p0_transpose_item(const float* W, int K, int N, bf16* WT, int dst_row0, LAS float* scr, int k0, int n0, int lane, const float* ksc = nullptr  ) {
    float wv[32]; const GAS float* wp = (const GAS float*)W + (size_t)(k0 + (lane >> 5)) * N + n0 + (lane & 31);
#pragma unroll
    for (int i = 0; i < 32; ++i) wv[i] = wp[(size_t)(2 * i) * N];
#pragma unroll
    for (int i = 0; i < 32; ++i) scr[(2 * i + (lane >> 5)) * 33 + (lane & 31)] = wv[i];
    LDS_WAIT(); asm volatile("" ::: "memory");
    const int c = lane & 7;
    f32x4 k0v = {1.f, 1.f, 1.f, 1.f}, k1v = k0v; if (ksc) { k0v = *(const GAS f32x4*)(ksc + k0 + 8 * c); k1v = *(const GAS f32x4*)(ksc + k0 + 8 * c + 4); }
#pragma unroll
    for (int j = 0; j < 4; ++j) { const int n = (lane >> 3) + 8 * j; const LAS float* s = scr + (8 * c) * 33 + n;
        v4u o; o.x = pk2(s[0 * 33] * k0v[0], s[1 * 33] * k0v[1]); o.y = pk2(s[2 * 33] * k0v[2], s[3 * 33] * k0v[3]); o.z = pk2(s[4 * 33] * k1v[0], s[5 * 33] * k1v[1]); o.w = pk2(s[6 * 33] * k1v[2], s[7 * 33] * k1v[3]);
        *(GAS v4u*)(WT + (size_t)(dst_row0 + n) * K + k0 + 8 * c) = o; }
    LDS_WAIT(); asm volatile("" ::: "memory");
}
__device__ __forceinline__ void rms_row_to_bf16(const float* xrow, const float* w, bf16* orow, int lane) {
    const GAS f32x4* xr = (const GAS f32x4*)xrow + lane;
    f32x4 v[16]; float s = 0.f;
#pragma unroll
    for (int j = 0; j < 16; ++j) { v[j] = xr[64 * j]; s += (v[j].x * v[j].x + v[j].y * v[j].y) + (v[j].z * v[j].z + v[j].w * v[j].w); }
    const float rstd = 1.f / sqrtf(wave_sum(s, lane) * (1.f / DM) + NORM_EPS);
    const GAS f32x4* wr = (const GAS f32x4*)w + lane; GAS v2u* o = (GAS v2u*)orow + lane;
#pragma unroll
    for (int j = 0; j < 16; ++j) { const f32x4 ww = wr[64 * j]; v2u q; q.x = pk2(v[j].x * rstd * ww.x, v[j].y * rstd * ww.y); q.y = pk2(v[j].z * rstd * ww.z, v[j].w * rstd * ww.w); o[64 * j] = q; }
}
__device__ __forceinline__ void p0_prologue(Frame& F) {
    LAS float* scr = (LAS float*)(F.lds + RING_OFF + F.wave * 16384);
    const int gw = F.bx * NWAVES + F.wave, NGW = F.G * NWAVES;
    const float* w_in = INP(11); const float* w_mem_kv = INP(24); const float* w_out = INP(25);
    constexpr int NB1 = DIN / 32  , I_IN = 64 * NB1, I_MK = 64 * (NMKV / 32), I_WO = 64 * (DM / 32);
    constexpr int NITEMS = 2 * (I_IN + I_MK + I_WO);
#pragma unroll 1
    for (int it = gw; it < NITEMS; it += NGW) {
        int r = it; const int l = r / (I_IN + I_MK + I_WO); r -= l * (I_IN + I_MK + I_WO);
        bf16* W1l = WSB(WS_W1) + (size_t)l * NW1 * DM;
        if (r < I_IN) { const int kb = r / NB1, nb = r % NB1; const int db = nb < 160 ? nb : (nb == 160 ? 352 : nb - 1);
            p0_transpose_item(w_in + (size_t)l * DM * DIN, DM, DIN, W1l, db * 32, scr, kb * 64, nb * 32, F.lane, l == 1 ? INP(9  ) + DM : nullptr); continue; }
        r -= I_IN;
        if (r < I_MK) { const int kb = r / (NMKV / 32), nb = r % (NMKV / 32);
            p0_transpose_item(w_mem_kv + (size_t)l * DM * NMKV, DM, NMKV, W1l, N1P + nb * 32, scr, kb * 64, nb * 32, F.lane); continue; }
        r -= I_MK;
        { const int kb = r / (DM / 32), nb = r % (DM / 32);
            p0_transpose_item(w_out + (size_t)l * DM * DM, DM, DM, WSB(WS_WO) + (size_t)l * DM * DM, nb * 32, scr, kb * 64, nb * 32, F.lane); }
    }
#pragma unroll 1
    for (int it = gw; it < 2 * (N1P - 11296); it += NGW) { const int l = it / (N1P - 11296), rr = 11296 + it % (N1P - 11296);
        GAS v4u* o = (GAS v4u*)(WSB(WS_W1) + (size_t)l * NW1 * DM + (size_t)rr * DM) + F.lane;
        unsigned zz = 0u; asm volatile("" : "+v"(zz));
#pragma unroll
        for (int j = 0; j < 8; ++j) o[64 * j] = (v4u){zz, zz, zz, zz}; }
    const float* x_prompt = INP(0); const float* x_sample = INP(1); const float* mem_prompt = INP(2); const float* norm_pre_w = INP(9); const float* mem_norm_w = INP(23);
#pragma unroll 1
    for (int m = gw; m < MT + 2 * NMROWS; m += NGW) {
        if (m < MP) rms_row_to_bf16(x_prompt + (size_t)m * DM, norm_pre_w, WSB(WS_HALL) + (size_t)m * DM, F.lane);
        else if (m < MT) rms_row_to_bf16(x_sample + (size_t)(m - MP) * DM, norm_pre_w, WSB(WS_HALL) + (size_t)m * DM, F.lane);
        else { const int q = m - MT, l = q / NMROWS, r = q % NMROWS; rms_row_to_bf16(mem_prompt + (size_t)r * DM, mem_norm_w + l * DM, WSB(WS_HALL) + (size_t)m * DM, F.lane); }
    }
}

struct Sched1 {
    int G, c, mem_pm0;
    __device__ __forceinline__ bool next(int i, pg8::Unit& u) const {
        long L = (long)i * G + c; constexpr int NR = 65 * 45; u.kb = 0;
        if (L < NR) { pg8::rect_tile((int)L, 65, 45, u.pm, u.pn); return true; }
        L -= NR; if (L < 32) { u.pm = mem_pm0 + (int)(L & 3); u.pn = T_MEM + (int)(L >> 2); return true; }
        return false;
    }
};
struct Sched2 {
    int G, c;
    __device__ __forceinline__ bool next(int i, pg8::Unit& u) const {
        const long L = (long)i * G + c; u.kb = 0; if (L >= 64 * 16) return false; pg8::rect_tile((int)L, 64, 16, u.pm, u.pn); return true; }
};
struct Sched2S {
    int G, c;
    __device__ __forceinline__ bool next(int i, pg8::Unit& u) const {
        const long L = (long)i * G + c; if (L >= 256) return false; u.pm = PM_S; u.pn = (int)(L >> 4); u.kb = (int)(L & 15) * 256 * 2; return true; }
};

__device__ __forceinline__ void st_bf8(bf16* p, const f32x4& v0, const f32x4& v1) {
    v4u w; w.x = pk2(v0[0], v0[1]); w.y = pk2(v0[2], v0[3]); w.z = pk2(v1[0], v1[1]); w.w = pk2(v1[2], v1[3]); *(GAS v4u*)p = w; }
__device__ __forceinline__ void st_f8(float* p, const f32x4& v0, const f32x4& v1) { *(GAS f32x4*)p = v0; *(GAS f32x4*)(p + 4) = v1; }

struct Epi1 {
    static constexpr bool PERM = true;
    unsigned char* ws; float* out; const float* dt_bias; int layer, mem_pm0;
    __device__ __forceinline__ void operator()(const f32x4 (&acc)[2][2][4][2], const pg8::Unit& u, int wr, int wc, int fr, int fq) const {
        const int pn = u.pn, pm = u.pm, cl = wc * 32 + 8 * fq, rl = wr * 64 + fr;
#define EB(off) ((bf16*)(ws + (off)))
        float* const DT = (float*)(ws + WS_DT); const float* const RS1 = (const float*)(ws + WS_RS1);
        float* const o_pk = out + O_PK + (size_t)layer * MP * 1024; float* const o_pv = out + O_PV + (size_t)layer * MP * 1024;
        float* const o_sk = out + O_SK + (size_t)layer * MS * 1024; float* const o_sv = out + O_SV + (size_t)layer * MS * 1024;
        float* const o_pconv = out + O_PCONV + (size_t)layer * NB * 3 * DCONV; float* const o_sconv = out + O_SCONV + (size_t)layer * SB * 3 * DCONV;
        float* const o_pmk = out + O_PMK + (size_t)layer * NMROWS * 1024; float* const o_pmv = out + O_PMV + (size_t)layer * NMROWS * 1024;
        if (pn == T_DT) {
            if (wc == 0) {
                const f32x4 b0 = *(const GAS f32x4*)(dt_bias + 8 * fq), b1 = *(const GAS f32x4*)(dt_bias + 8 * fq + 4);
#pragma unroll
                for (int ai = 0; ai < 2; ++ai)
#pragma unroll
                    for (int m = 0; m < 4; ++m) { const size_t row = (size_t)pm * 256 + ai * 128 + m * 16 + rl; const float rs = layer == 1 ? RS1[row] : 1.f; f32x4 v0 = acc[ai][0][m][0] * rs + b0, v1 = acc[ai][0][m][1] * rs + b1;
#pragma unroll
                        for (int e = 0; e < 4; ++e) { v0[e] = softplus(v0[e]); v1[e] = softplus(v1[e]); }
                        st_f8(DT + row * 32 + 8 * fq, v0, v1); __builtin_amdgcn_sched_barrier(0); }
            }
            return;
        }
        bf16* bb; float* ff = nullptr; int bld = 1024, mode = 0, rowbase = pm * 256, ct;
        if (pn >= T_MEM) { ct = (pn - T_MEM) & 3; const bool isK = (pn - T_MEM) < 4; bb = isK ? EB(WS_MK) : EB(WS_MV); ff = isK ? o_pmk : o_pmv; rowbase = (pm - mem_pm0) * 256; }
        else if (pn >= T_GM) { bb = EB(WS_GM); ct = pn - T_GM; }
        else if (pn >= T_QM) { bb = EB(WS_QM); ct = pn - T_QM; }
        else if (pn >= T_GD) { bb = EB(WS_GD); ct = pn - T_GD; }
        else if (pn >= T_KD) { const bool isK = pn < T_VD; ct = pn - (isK ? T_KD : T_VD);
            if (pm < PM_S) { bb = isK ? EB(WS_KD) : EB(WS_VD); ff = isK ? o_pk : o_pv; } else { bb = isK ? EB(WS_KS) : EB(WS_VS); ff = isK ? o_sk : o_sv; mode = 1; } }
        else if (pn >= T_QD) { bb = EB(WS_QD); ct = pn - T_QD; }
        else if (pn >= T_XBC) { bb = EB(WS_XBC); bld = DCONV; ct = pn - T_XBC; mode = 2; }
        else { bb = EB(WS_Z); bld = DSSM; ct = pn; }
        const int col = ct * 256 + cl;
#pragma unroll
        for (int ai = 0; ai < 2; ++ai)
#pragma unroll
            for (int m = 0; m < 4; ++m) {
                const int r = ai * 128 + m * 16 + rl; size_t bo, fo = 0; bool fok = ff != nullptr; float* fp = ff;
                if (mode == 1) { bo = ((size_t)(r >> 4) * LKSP + PAST + (r & 15)) * 1024 + col; fo = (size_t)r * 1024 + col; }
                else { bo = (size_t)(rowbase + r) * bld + col; fo = (size_t)(rowbase + r) * 1024 + col; }
                if (mode == 2) { const int row = rowbase + r; fok = false;
                    if (pm < PM_S) { const int t = row & (SEQ - 1); if (t >= SEQ - 3) { fok = true; fp = o_pconv; fo = (size_t)((row >> 12) * 3 + (t - (SEQ - 3))) * DCONV + col; } }
                    else { const int sr = row - MP, i = sr & 15; if (i >= SL - 3) { fok = true; fp = o_sconv; fo = (size_t)((sr >> 4) * 3 + (i - (SL - 3))) * DCONV + col; } } }
                const float rs = (layer == 1 && pm <= PM_S) ? RS1[pm * 256 + r] : 1.f;
#pragma unroll
                for (int bj = 0; bj < 2; ++bj) { const f32x4 v0 = acc[ai][bj][m][0] * rs, v1 = acc[ai][bj][m][1] * rs; st_bf8(bb + bo + bj * 128, v0, v1); if (fok) st_f8(fp + fo + bj * 128, v0, v1); }
                __builtin_amdgcn_sched_barrier(0);
            }
#undef EB
    }
};
struct Epi2 {
    static constexpr bool PERM = true; bf16* O;
    __device__ __forceinline__ void operator()(const f32x4 (&acc)[2][2][4][2], const pg8::Unit& u, int wr, int wc, int fr, int fq) const {
        const int cl = wc * 32 + 8 * fq, rl = wr * 64 + fr;
#pragma unroll
        for (int ai = 0; ai < 2; ++ai)
#pragma unroll
            for (int m = 0; m < 4; ++m) { const size_t row = (size_t)u.pm * 256 + ai * 128 + m * 16 + rl;
#pragma unroll
                for (int bj = 0; bj < 2; ++bj) st_bf8(O + row * DM + u.pn * 256 + bj * 128 + cl, acc[ai][bj][m][0], acc[ai][bj][m][1]); __builtin_amdgcn_sched_barrier(0); }
    }
};
struct Sched2F {
    int G, c;
    __device__ __forceinline__ bool next(int i, pg8::Unit& u) const {
        if (i >= 4) return false; const int x = c & 7, j = c >> 3; u.kb = 0; u.pm = 16 * (x >> 1) + 4 * i + (j & 3); u.pn = 8 * (x & 1) + (j >> 2); return true; }
};
template <int LAYER>
struct Epi2F {
    static constexpr bool PERM = true;
    unsigned char* ws; float* out; const float* wpost; const float* xres; LAS unsigned char* xl;
    __device__ __forceinline__ void ldres(v4u (&d)[2][2], size_t go) const {
#pragma unroll
        for (int bj = 0; bj < 2; ++bj) {
            if (LAYER == 0) { d[bj][0] = *(const GAS v4u*)(xres + go + bj * 128); d[bj][1] = *(const GAS v4u*)(xres + go + bj * 128 + 4); }
            else d[bj][0] = *(const GAS v4u*)((const bf16*)xres + go + bj * 128); }
    }
    __device__ __forceinline__ void operator()(const f32x4 (&acc)[2][2][4][2], const pg8::Unit& u, int wr, int wc, int fr, int fq) const {
        const int lane = fq * 16 + fr, wid = wr * 4 + wc, pm = u.pm, pn = u.pn;
        LAS float* P = (LAS float*)xl; LAS float* S = (LAS float*)(xl + 4096);
        unsigned* cnt = (unsigned*)(ws + WS_CTL) + CW_XC + (LAYER * 64 + pm) * 64;
        float* slots = (float*)(ws + WS_XS1) + (size_t)pm * 256 * 16;
        const int cl = wc * 32 + 8 * fq, rl = wr * 64 + fr, gc = pn * 256 + cl;
        f32x4 wv[2][2];
#pragma unroll
        for (int bj = 0; bj < 2; ++bj) { wv[bj][0] = *(const GAS f32x4*)(wpost + gc + bj * 128); wv[bj][1] = *(const GAS f32x4*)(wpost + gc + bj * 128 + 4); }
        v4u pre[4][2][2];
#pragma unroll
        for (int m = 0; m < 4; ++m) ldres(pre[m], (size_t)(pm * 256 + m * 16 + rl) * DM + gc);
#pragma unroll
        for (int ai = 0; ai < 2; ++ai)
#pragma unroll
            for (int m = 0; m < 4; ++m) { float s = 0.f;
#pragma unroll
                for (int bj = 0; bj < 2; ++bj)
#pragma unroll
                    for (int n = 0; n < 2; ++n) { const f32x4 x = acc[ai][bj][m][n]; s += (x[0] * x[0] + x[1] * x[1]) + (x[2] * x[2] + x[3] * x[3]); }
                s += shx(s, lane, 16); s += shx(s, lane, 32);
                if (fq == 0) P[(ai * 128 + m * 16 + rl) * 4 + wc] = s; }
        LDS_WAIT(); __builtin_amdgcn_s_barrier(); asm volatile("" ::: "memory");
        const int row = wid * 32 + (lane & 31);
        if (lane < 32) { const f32x4 p = *(const LAS f32x4*)(P + row * 4); __hip_atomic_store(slots + row * 16 + pn, (p[0] + p[1]) + (p[2] + p[3]), __ATOMIC_RELAXED, __HIP_MEMORY_SCOPE_AGENT); }
        asm volatile("s_waitcnt vmcnt(0)" ::: "memory");
        if (lane == 0) (void)__hip_atomic_fetch_add(cnt, 1u, __ATOMIC_RELAXED, __HIP_MEMORY_SCOPE_AGENT);
        if (wid == 0) { unsigned sp = 0u;
            while ((unsigned)__builtin_amdgcn_readfirstlane(__hip_atomic_load(cnt, __ATOMIC_RELAXED, __HIP_MEMORY_SCOPE_AGENT)) < 128u) { __builtin_amdgcn_s_sleep(2); if (++sp > (1u << 22)) break; }
            __builtin_amdgcn_fence(__ATOMIC_ACQUIRE, "agent"); }
        asm volatile("s_waitcnt vmcnt(0) lgkmcnt(0)" ::: "memory"); __builtin_amdgcn_s_barrier(); asm volatile("" ::: "memory");
        if (lane < 32) { const unsigned long long* sl = (const unsigned long long*)(slots + row * 16); float t = 0.f;
#pragma unroll
            for (int k = 0; k < 8; ++k) { const unsigned long long w = __hip_atomic_load(sl + k, __ATOMIC_RELAXED, __HIP_MEMORY_SCOPE_AGENT); t += __uint_as_float((unsigned)w) + __uint_as_float((unsigned)(w >> 32)); }
            S[row] = 1.f / sqrtf(t * (1.f / DM) + NORM_EPS); }
        LDS_WAIT(); __builtin_amdgcn_s_barrier(); asm volatile("" ::: "memory");
#pragma unroll
        for (int ai = 0; ai < 2; ++ai) {
            if (ai == 1) {
#pragma unroll
                for (int m = 0; m < 4; ++m) ldres(pre[m], (size_t)(pm * 256 + 128 + m * 16 + rl) * DM + gc); }
#pragma unroll
            for (int m = 0; m < 4; ++m) { const int r = ai * 128 + m * 16 + rl; const float rs = S[r]; const size_t go = (size_t)(pm * 256 + r) * DM + gc; float s2 = 0.f;
#pragma unroll
                for (int bj = 0; bj < 2; ++bj) { f32x4 x0, x1;
                    if (LAYER == 0) { x0 = __builtin_bit_cast(f32x4, pre[m][bj][0]); x1 = __builtin_bit_cast(f32x4, pre[m][bj][1]); }
                    else { const v4u q = pre[m][bj][0]; x0 = (f32x4){bflo(q.x), bfhi(q.x), bflo(q.y), bfhi(q.y)}; x1 = (f32x4){bflo(q.z), bfhi(q.z), bflo(q.w), bfhi(q.w)}; }
                    const f32x4 y0 = x0 + acc[ai][bj][m][0] * rs * wv[bj][0], y1 = x1 + acc[ai][bj][m][1] * rs * wv[bj][1];
                    if (LAYER == 1) st_f8(out + go + bj * 128, y0, y1);
                    else { st_bf8((bf16*)(ws + WS_HALL) + go + bj * 128, y0, y1);
                        s2 += ((y0[0] * y0[0] + y0[1] * y0[1]) + (y0[2] * y0[2] + y0[3] * y0[3])) + ((y1[0] * y1[0] + y1[1] * y1[1]) + (y1[2] * y1[2] + y1[3] * y1[3])); } }
                if (LAYER == 0) { s2 += shx(s2, lane, 16); s2 += shx(s2, lane, 32); if (fq == 0) P[r * 4 + wc] = s2; }
                __builtin_amdgcn_sched_barrier(0); }
        }
        if (LAYER == 0) {
            LDS_WAIT(); __builtin_amdgcn_s_barrier(); asm volatile("" ::: "memory");
            if (lane < 32) { const f32x4 p = *(const LAS f32x4*)(P + row * 4); ((float*)(ws + WS_XS2))[(size_t)(pm * 256 + row) * 16 + pn] = (p[0] + p[1]) + (p[2] + p[3]); }
        }
    }
};
struct Epi2S {
    static constexpr bool PERM = true; float* O;
    __device__ __forceinline__ void operator()(const f32x4 (&acc)[2][2][4][2], const pg8::Unit& u, int wr, int wc, int fr, int fq) const {
        const int cl = wc * 32 + 8 * fq, rl = wr * 64 + fr; float* base = O + (size_t)(u.kb >> 9) * MS * DM + u.pn * 256 + cl;
#pragma unroll
        for (int ai = 0; ai < 2; ++ai)
#pragma unroll
            for (int m = 0; m < 4; ++m) { const size_t row = (size_t)ai * 128 + m * 16 + rl;
#pragma unroll
                for (int bj = 0; bj < 2; ++bj) st_f8(base + row * DM + bj * 128, acc[ai][bj][m][0], acc[ai][bj][m][1]);
                __builtin_amdgcn_sched_barrier(0); }
    }
};

__device__ __forceinline__ v4u pack8(const float (&o)[8]) { v4u w; w.x = pk2(o[0], o[1]); w.y = pk2(o[2], o[3]); w.z = pk2(o[4], o[5]); w.w = pk2(o[6], o[7]); return w; }
__device__ __forceinline__ void cvt8(const float* src, bf16* dst) {
    const f32x4 a = *(const GAS f32x4*)src, b = *(const GAS f32x4*)(src + 4); v4u w; w.x = pk2(a.x, a.y); w.y = pk2(a.z, a.w); w.z = pk2(b.x, b.y); w.w = pk2(b.z, b.w); *(GAS v4u*)dst = w; }
template <int LEN>
__device__ __forceinline__ void conv_item(const Frame& F, const bf16* XBC, int row0, int ck, int cb, float2 h0, float2 h1, float2 h2, const float* conv_w, const float* conv_b) {
    const int c = cb * 128 + 2 * F.lane;
    const f32x2_t w0 = *(const GAS f32x2_t*)(conv_w + c), w1 = *(const GAS f32x2_t*)(conv_w + DCONV + c), w2 = *(const GAS f32x2_t*)(conv_w + 2 * DCONV + c), w3 = *(const GAS f32x2_t*)(conv_w + 3 * DCONV + c);
    const f32x2_t bias = *(const GAS f32x2_t*)(conv_b + c);
    unsigned xin[LEN];
    const GAS unsigned* xp = (const GAS unsigned*)(XBC + (size_t)row0 * DCONV + c);
#pragma unroll
    for (int t = 0; t < LEN; ++t) xin[t] = xp[(size_t)t * (DCONV / 2)];
    float a0 = h0.x, a1 = h1.x, a2 = h2.x, b0 = h0.y, b1 = h1.y, b2 = h2.y;
#pragma unroll
    for (int t8 = 0; t8 < LEN; t8 += 8) {
        float oa[8], ob[8];
#pragma unroll
        for (int j = 0; j < 8; ++j) { const float xa = bflo(xin[t8 + j]), xb = bfhi(xin[t8 + j]);
            oa[j] = silu(bias.x + w0.x * a0 + w1.x * a1 + w2.x * a2 + w3.x * xa); ob[j] = silu(bias.y + w0.y * b0 + w1.y * b1 + w2.y * b2 + w3.y * xb);
            a0 = a1; a1 = a2; a2 = xa; b0 = b1; b1 = b2; b2 = xb; }
        if (LEN == 64 && cb < 20) { LAS unsigned char* tp = F.lds + F.wave * 18432 + (2 * F.lane) * 144 + t8 * 2; *(LAS v4u*)tp = pack8(oa); *(LAS v4u*)(tp + 144) = pack8(ob); }
        else if (cb < 16) { bf16* xt = WSB(WS_XT) + ((size_t)ck * DSSM + c) * 64 + t8; *(GAS v4u*)xt = pack8(oa); *(GAS v4u*)(xt + 64) = pack8(ob); }
        if (cb >= 16 && cb < 20) { const int n = c - DSSM; if (LEN != 64) { bf16* bt = WSB(WS_BT) + ((size_t)ck * GB + n) * 64 + t8; *(GAS v4u*)bt = pack8(oa); *(GAS v4u*)(bt + 64) = pack8(ob); }
            GAS unsigned* bk = (GAS unsigned*)(WSB(WS_BTOK) + (size_t)(row0 + t8) * GB + n);
#pragma unroll
            for (int j = 0; j < 8; ++j) bk[(size_t)j * (GB / 2)] = pk2(oa[j], ob[j]); }
        else if (cb >= 20) { const int n = c - DSSM - GB; GAS unsigned* ckp = (GAS unsigned*)(WSB(WS_CTOK) + (size_t)(row0 + t8) * GB + n);
#pragma unroll
            for (int j = 0; j < 8; ++j) ckp[(size_t)j * (GB / 2)] = pk2(oa[j], ob[j]); }
    }
    if (LEN == 64 && cb < 20) {
        LDS_WAIT(); asm volatile("" ::: "memory");
        const LAS unsigned char* tr = F.lds + F.wave * 18432 + (F.lane >> 3) * 144 + (F.lane & 7) * 16;
        bf16* dst = (cb < 16 ? WSB(WS_XT) + ((size_t)ck * DSSM + cb * 128) * 64 : WSB(WS_BT) + ((size_t)ck * GB + (cb - 16) * 128) * 64) + (F.lane >> 3) * 64 + (F.lane & 7) * 8;
#pragma unroll
        for (int it = 0; it < 16; ++it) *(GAS v4u*)(dst + (8 * it) * 64) = *(const LAS v4u*)(tr + (8 * it) * 144);
        LDS_WAIT(); asm volatile("" ::: "memory");
    }
}
__device__ __forceinline__ void conv_phase(Frame& F, int layer) {
    const int gw = F.bx * NWAVES + F.wave, NGW = F.G * NWAVES, lane = F.lane;
    constexpr int NCB = DCONV / 128, NPI = (MP / 64) * NCB, NSI = SB * NCB;
    const float* cache_conv = INP(3); const float* conv_w = INP(12) + (size_t)layer * 4 * DCONV; const float* conv_b = INP(13) + layer * DCONV;
    const bf16* XBC = WSB(WS_XBC);
#pragma unroll 1
    for (int it = gw; it < NPI + NSI; it += NGW) {
        if (it < NPI) { const int ck = it / NCB, cb = it % NCB, row0 = ck * 64, c = cb * 128 + 2 * lane;
            float2 h0 = {0.f, 0.f}, h1 = {0.f, 0.f}, h2 = {0.f, 0.f};
            if ((ck & (NCH - 1)) != 0) { const GAS unsigned* hp = (const GAS unsigned*)(XBC + (size_t)(row0 - 3) * DCONV + c); const unsigned u0 = hp[0], u1 = hp[DCONV / 2], u2 = hp[DCONV];
                h0 = {bflo(u0), bfhi(u0)}; h1 = {bflo(u1), bfhi(u1)}; h2 = {bflo(u2), bfhi(u2)}; }
            conv_item<64>(F, XBC, row0, ck, cb, h0, h1, h2, conv_w, conv_b); }
        else { const int v = it - NPI, b = v / NCB, cb = v % NCB, row0 = MP + b * SL, c = cb * 128 + 2 * lane;
            const float* cc = cache_conv + (size_t)((layer * SB + b) * 3) * DCONV + c;
            const f32x2_t q0 = *(const GAS f32x2_t*)cc, q1 = *(const GAS f32x2_t*)(cc + DCONV), q2 = *(const GAS f32x2_t*)(cc + 2 * DCONV);
            conv_item<SL>(F, XBC, row0, MP / 64 + b, cb, float2{q0.x, q0.y}, float2{q1.x, q1.y}, float2{q2.x, q2.y}, conv_w, conv_b); }
    }
}
__device__ __forceinline__ void cache_convert(Frame& F, int layer, int rank, int nranks) {
    const size_t gt = (size_t)rank * (NWAVES * 64) + F.tid, NT = (size_t)nranks * (NWAVES * 64);
    { const float* sk = INP(5  ) + (size_t)layer * SB * PAST * 1024; const float* sv = INP(6  ) + (size_t)layer * SB * PAST * 1024;
#pragma unroll 2
      for (size_t i = gt; i < (size_t)SB * PAST * 128; i += NT) { const size_t b = i / (PAST * 128), rem = i % (PAST * 128);
          cvt8(sk + i * 8, WSB(WS_KS) + b * LKSP * 1024 + rem * 8); cvt8(sv + i * 8, WSB(WS_VS) + b * LKSP * 1024 + rem * 8); } }
    { const float* sk = INP(7  ) + (size_t)layer * SB * NMEM * 1024; const float* sv = INP(8  ) + (size_t)layer * SB * NMEM * 1024;
#pragma unroll 2
      for (size_t i = gt; i < (size_t)SB * NMEM * 128; i += NT) { cvt8(sk + i * 8, WSB(WS_MKS) + i * 8); cvt8(sv + i * 8, WSB(WS_MVS) + i * 8); } }
}

#define MFMA32(a, b, c) __builtin_amdgcn_mfma_f32_32x32x16_bf16((a), (b), (c), 0, 0, 0)
constexpr int SSD_YB = 17408;
constexpr int SSD_SM_OFF = 8 * SSD_YB;
constexpr int SSD_RS_OFF = SSD_SM_OFF + 8 * 768;
static_assert(SSD_RS_OFF + 2048 <= RING_BYTES, "SSD LDS map");
struct SsdUnit { int b, c, g, row0, len, ck; bool smp; };
__device__ __forceinline__ SsdUnit ssd_unit(int u) {
    SsdUnit s; s.smp = u >= NB * NCH * NG;
    if (!s.smp) { s.b = u >> 8; s.c = (u >> 2) & (NCH - 1); s.g = u & 3; s.row0 = s.b * SEQ + s.c * 64; s.len = 64; s.ck = s.row0 >> 6; }
    else { const int v = u - NB * NCH * NG; s.b = v >> 2; s.c = 0; s.g = v & 3; s.row0 = MP + s.b * SL; s.len = SL; s.ck = MP / 64 + s.b; }
    return s;
}
constexpr int NSSD_UNITS = NB * NCH * NG + SB * NG;
__device__ __forceinline__ void ssd_dt_cum_l(const Frame& F, const float* a_log_l, const SsdUnit& s, int hd, int lane, float& dtv, float& cum, float& clast) {
    dtv = lane < s.len ? WSF(WS_DT)[(size_t)(s.row0 + lane) * 32 + hd] : 0.f;
    const float Ah = -__expf(a_log_l[hd]);
    cum = dtv * Ah;
#pragma unroll
    for (int o = 1; o < 64; o <<= 1) { const float t = shl_from(cum, lane - o); if (lane >= o) cum += t; }
    clast = shl_from(cum, 63);
}
__device__ __forceinline__ void ssd_dt_cum(const Frame& F, const float* a_log_l, const SsdUnit& s, int hd, float& dtv, float& cum, float& clast) { ssd_dt_cum_l(F, a_log_l, s, hd, F.lane, dtv, cum, clast); }
__device__ __forceinline__ bf16x8 scale_bf8(const v4u raw, const f32x4 w0, const f32x4 w1) {
    v4u o; o.x = pk2(bflo(raw.x) * w0.x, bfhi(raw.x) * w0.y); o.y = pk2(bflo(raw.y) * w0.z, bfhi(raw.y) * w0.w);
    o.z = pk2(bflo(raw.z) * w1.x, bfhi(raw.z) * w1.y); o.w = pk2(bflo(raw.w) * w1.z, bfhi(raw.w) * w1.w); return __builtin_bit_cast(bf16x8, o); }
__device__ __forceinline__ bf16x8 f8_to_bf8(const float* p) {
    const f32x4 a = *(const GAS f32x4*)p, b = *(const GAS f32x4*)(p + 4); v4u o; o.x = pk2(a.x, a.y); o.y = pk2(a.z, a.w); o.z = pk2(b.x, b.y); o.w = pk2(b.z, b.w); return __builtin_bit_cast(bf16x8, o); }

__device__ __forceinline__ void ssd_pass_a(Frame& F, int layer, int u0, int u1, int ustep) {
    const int lane = F.lane, r = lane & 31, hh = lane >> 5;
    LAS float* wb = (LAS float*)(F.lds + SSD_SM_OFF) + F.wave * 192;
    const float zf = zero_asm();
    const float* a_log_l = INP(15) + layer * NH; const float* state_ssm = INP(4);
#pragma unroll 1
    for (int u = u0; u < u1; u += ustep) {
        const SsdUnit s = ssd_unit(u); const int hd = s.g * 8 + F.wave;
        float dtv, cum, cl; ssd_dt_cum(F, a_log_l, s, hd, dtv, cum, cl);
        wb[lane] = dtv * fexp(cl - cum);
        LDS_WAIT(); asm volatile("" ::: "memory");
        f32x16 acc[4][2];
#pragma unroll
        for (int nt = 0; nt < 4; ++nt)
#pragma unroll
            for (int pt = 0; pt < 2; ++pt)
#pragma unroll
                for (int e = 0; e < 16; ++e) acc[nt][pt][e] = zf;
        const bf16* xt = WSB(WS_XT) + ((size_t)s.ck * DSSM + hd * 64 + r) * 64 + 8 * hh;
        const bf16* bt = WSB(WS_BT) + ((size_t)s.ck * GB + s.g * DST + r) * 64 + 8 * hh;
#pragma unroll
        for (int ks = 0; ks < 4; ++ks) {
            const f32x4 w0 = *(const LAS f32x4*)(wb + 16 * ks + 8 * hh), w1 = *(const LAS f32x4*)(wb + 16 * ks + 8 * hh + 4);
            bf16x8 a[2], bb[4];
#pragma unroll
            for (int pt = 0; pt < 2; ++pt) a[pt] = scale_bf8(*(const GAS v4u*)(xt + (32 * pt) * 64 + 16 * ks), w0, w1);
#pragma unroll
            for (int nt = 0; nt < 4; ++nt) bb[nt] = *(const GAS bf16x8*)(bt + (32 * nt) * 64 + 16 * ks);
#pragma unroll
            for (int nt = 0; nt < 4; ++nt)
#pragma unroll
                for (int pt = 0; pt < 2; ++pt) acc[nt][pt] = MFMA32(bb[nt], a[pt], acc[nt][pt]);
        }
        const float dc = fexp(cl);
        int ro = r * DST + 4 * hh; asm volatile("" : "+v"(ro));
        if (!s.smp) {
            LAS unsigned char* tb = F.lds + F.wave * SSD_YB;
#pragma unroll
            for (int nt = 0; nt < 4; ++nt)
#pragma unroll
                for (int pt = 0; pt < 2; ++pt)
#pragma unroll
                    for (int q4 = 0; q4 < 4; ++q4) { v2u o; o.x = pk2(acc[nt][pt][4 * q4], acc[nt][pt][4 * q4 + 1]); o.y = pk2(acc[nt][pt][4 * q4 + 2], acc[nt][pt][4 * q4 + 3]);
                        *(LAS v2u*)(tb + (32 * pt + r) * 272 + (32 * nt + 8 * q4 + 4 * hh) * 2) = o; }
            LDS_WAIT(); asm volatile("" ::: "memory");
            bf16* st = WSB(WS_ST) + (size_t)((s.b * NCH + s.c) * NH + hd) * 8192 + lane * 8;
#pragma unroll
            for (int it = 0; it < 16; ++it) *(GAS v4u*)(st + it * 512) = *(const LAS v4u*)(tb + (32 * (it & 1) + r) * 272 + (16 * (it >> 1) + 8 * hh) * 2);
            LDS_WAIT(); asm volatile("" ::: "memory");
            if (lane == 0) WSF(WS_DC)[(s.b * NCH + s.c) * NH + hd] = dc;
        } else {
            const size_t base = ((size_t)(layer * SB + s.b) * NH + hd) * 8192 + ro;
            const float* h0 = state_ssm + base; float* ho = (float*)(F.out + O_SSSM + base);
#pragma unroll
            for (int nt = 0; nt < 4; ++nt) {
#pragma unroll
                for (int pt = 0; pt < 2; ++pt)
#pragma unroll
                    for (int q4 = 0; q4 < 4; ++q4) { const int o = (32 * pt) * DST + 32 * nt + 8 * q4; const f32x4 hv = *(const GAS f32x4*)(h0 + o);
                        *(GAS f32x4*)(ho + o) = (f32x4){hv.x * dc + acc[nt][pt][4 * q4], hv.y * dc + acc[nt][pt][4 * q4 + 1], hv.z * dc + acc[nt][pt][4 * q4 + 2], hv.w * dc + acc[nt][pt][4 * q4 + 3]}; }
                __builtin_amdgcn_sched_barrier(0); }
        }
        LDS_WAIT(); asm volatile("" ::: "memory");
    }
}

__device__ __forceinline__ void ssd_pass_b(Frame& F, int layer) {
    const size_t gt = (size_t)F.bx * (NWAVES * 64) + F.tid, NT = (size_t)F.G * (NWAVES * 64);
#pragma unroll 1
    for (size_t idx = gt; idx < (size_t)NB * NH * 1024; idx += NT) {
        const int bh = (int)(idx >> 10), e8 = (int)(idx & 1023), b = bh >> 5, hd = bh & 31;
        GAS v4u* p = (GAS v4u*)WSB(WS_ST) + ((size_t)(b * NCH) * NH + hd) * 1024 + e8;
        const float* dcp = WSF(WS_DC) + (b * NCH) * NH + hd;
        const float zf = zero_asm(); float h[8];
#pragma unroll
        for (int k = 0; k < 8; ++k) h[k] = zf;
#pragma unroll 1
        for (int c0 = 0; c0 < NCH; c0 += 8) {
            v4u t[8]; float d[8];
#pragma unroll
            for (int j = 0; j < 8; ++j) { t[j] = p[(size_t)j * NH * 1024]; d[j] = dcp[j * NH]; }
#pragma unroll
            for (int j = 0; j < 8; ++j) { v4u o; o.x = pk2(h[0], h[1]); o.y = pk2(h[2], h[3]); o.z = pk2(h[4], h[5]); o.w = pk2(h[6], h[7]); p[(size_t)j * NH * 1024] = o;
                h[0] = h[0] * d[j] + bflo(t[j].x); h[1] = h[1] * d[j] + bfhi(t[j].x); h[2] = h[2] * d[j] + bflo(t[j].y); h[3] = h[3] * d[j] + bfhi(t[j].y);
                h[4] = h[4] * d[j] + bflo(t[j].z); h[5] = h[5] * d[j] + bfhi(t[j].z); h[6] = h[6] * d[j] + bflo(t[j].w); h[7] = h[7] * d[j] + bfhi(t[j].w); }
            p += (size_t)8 * NH * 1024; dcp += 8 * NH;
        }
        const int pp = 32 * ((e8 >> 6) & 1) + (e8 & 31), nn = 16 * (e8 >> 7) + 8 * ((e8 >> 5) & 1);
        GAS f32x4* po = (GAS f32x4*)(F.out + O_PSSM) + ((size_t)(layer * NB + b) * NH + hd) * 2048 + pp * 32 + (nn >> 2);
        po[0] = (f32x4){h[0], h[1], h[2], h[3]}; po[1] = (f32x4){h[4], h[5], h[6], h[7]};
    }
}

__device__ __forceinline__ void ssd_pass_c(Frame& F, int layer, int u0, int u1, int ustep) {
    LAS float* cumb = (LAS float*)(F.lds + SSD_SM_OFF) + F.wave * 192; LAS float* dtb = cumb + 64; LAS float* ecb = cumb + 128;
    LAS float* yb = (LAS float*)(F.lds + F.wave * SSD_YB);
    LAS float* rsq = (LAS float*)(F.lds + SSD_RS_OFF);
    const float zf = zero_asm();
    const float* a_log_l = INP(15) + layer * NH; const float* state_ssm = INP(4); const float* d_skip_l = INP(16) + layer * NH; const float* ssm_norm_w_l = INP(17) + layer * DSSM;
#pragma unroll 1
    for (int u = u0; u < u1; u += ustep) {
        int lane = F.lane; asm volatile("" : "+v"(lane));
        const int r = lane & 31, hh = lane >> 5;
        const SsdUnit s = ssd_unit(u); const int hd = s.g * 8 + F.wave;
        float dtv, cum, cl; ssd_dt_cum(F, a_log_l, s, hd, dtv, cum, cl);
        cumb[lane] = cum; dtb[lane] = dtv; ecb[lane] = fexp(cum);
        LDS_WAIT(); asm volatile("" ::: "memory");
        f32x16 acc[2][2];
#pragma unroll
        for (int lt = 0; lt < 2; ++lt)
#pragma unroll
            for (int pt = 0; pt < 2; ++pt)
#pragma unroll
                for (int e = 0; e < 16; ++e) acc[lt][pt][e] = zf;
        const bf16* ctk = WSB(WS_CTOK) + (size_t)(s.row0 + r) * GB + s.g * DST + 8 * hh;
        const bf16* btk = WSB(WS_BTOK) + (size_t)(s.row0 + r) * GB + s.g * DST + 8 * hh;
        const float* hps = state_ssm + ((size_t)(layer * SB + (s.smp ? s.b : 0)) * NH + hd) * 8192 + (size_t)r * DST + 8 * hh;
        const bf16* hpp = WSB(WS_ST) + (size_t)(s.smp ? 0 : ((s.b * NCH + s.c) * NH + hd)) * 8192 + lane * 8;
#pragma unroll
        for (int ks = 0; ks < 8; ++ks) {
            bf16x8 cf[2], hf[2];
#pragma unroll
            for (int lt = 0; lt < 2; ++lt) cf[lt] = *(const GAS bf16x8*)(ctk + (size_t)(32 * lt) * GB + 16 * ks);
#pragma unroll
            for (int pt = 0; pt < 2; ++pt) hf[pt] = s.smp ? f8_to_bf8(hps + (32 * pt) * DST + 16 * ks) : *(const GAS bf16x8*)(hpp + (2 * ks + pt) * 512);
#pragma unroll
            for (int lt = 0; lt < 2; ++lt)
#pragma unroll
                for (int pt = 0; pt < 2; ++pt) acc[lt][pt] = MFMA32(cf[lt], hf[pt], acc[lt][pt]);
        }
#pragma unroll
        for (int lt = 0; lt < 2; ++lt)
#pragma unroll
            for (int q4 = 0; q4 < 4; ++q4) { const f32x4 sc4 = *(const LAS f32x4*)(ecb + 32 * lt + 8 * q4 + 4 * hh);
#pragma unroll
                for (int j = 0; j < 4; ++j) { acc[lt][0][4 * q4 + j] *= sc4[j]; acc[lt][1][4 * q4 + j] *= sc4[j]; } }
        f32x16 T00, T01, T11;
#pragma unroll
        for (int e = 0; e < 16; ++e) { T00[e] = zf; T01[e] = zf; T11[e] = zf; }
#pragma unroll
        for (int ks = 0; ks < 8; ++ks) {
            const bf16x8 b0 = *(const GAS bf16x8*)(btk + 16 * ks), b1 = *(const GAS bf16x8*)(btk + (size_t)32 * GB + 16 * ks);
            const bf16x8 c0 = *(const GAS bf16x8*)(ctk + 16 * ks), c1 = *(const GAS bf16x8*)(ctk + (size_t)32 * GB + 16 * ks);
            T00 = MFMA32(b0, c0, T00); T01 = MFMA32(b0, c1, T01); T11 = MFMA32(b1, c1, T11);
        }
        const float cl0 = cumb[r], cl1 = cumb[32 + r];
#pragma unroll
        for (int q4 = 0; q4 < 4; ++q4) { const int s0 = 8 * q4 + 4 * hh;
            const f32x4 cs0v = *(const LAS f32x4*)(cumb + s0), cs1v = *(const LAS f32x4*)(cumb + 32 + s0), d0v = *(const LAS f32x4*)(dtb + s0), d1v = *(const LAS f32x4*)(dtb + 32 + s0);
#pragma unroll
            for (int j = 0; j < 4; ++j) { const int e = 4 * q4 + j, si = s0 + j;
                T00[e] = (si <= r) ? T00[e] * fexp(fminf(cl0 - cs0v[j], 0.f)) * d0v[j] : 0.f;
                T01[e] = T01[e] * fexp(fminf(cl1 - cs0v[j], 0.f)) * d0v[j];
                T11[e] = (si <= r) ? T11[e] * fexp(fminf(cl1 - cs1v[j], 0.f)) * d1v[j] : 0.f; } }
        const bf16* xt = WSB(WS_XT) + ((size_t)s.ck * DSSM + hd * 64 + r) * 64 + 4 * hh;
#pragma unroll
        for (int sp = 0; sp < 2; ++sp) {
            v4u w00, w01, w11;
            w00.x = pk2(T00[8 * sp + 0], T00[8 * sp + 1]); w00.y = pk2(T00[8 * sp + 2], T00[8 * sp + 3]); w00.z = pk2(T00[8 * sp + 4], T00[8 * sp + 5]); w00.w = pk2(T00[8 * sp + 6], T00[8 * sp + 7]);
            w01.x = pk2(T01[8 * sp + 0], T01[8 * sp + 1]); w01.y = pk2(T01[8 * sp + 2], T01[8 * sp + 3]); w01.z = pk2(T01[8 * sp + 4], T01[8 * sp + 5]); w01.w = pk2(T01[8 * sp + 6], T01[8 * sp + 7]);
            w11.x = pk2(T11[8 * sp + 0], T11[8 * sp + 1]); w11.y = pk2(T11[8 * sp + 2], T11[8 * sp + 3]); w11.z = pk2(T11[8 * sp + 4], T11[8 * sp + 5]); w11.w = pk2(T11[8 * sp + 6], T11[8 * sp + 7]);
#pragma unroll
            for (int pt = 0; pt < 2; ++pt) {
                const bf16* xp = xt + (32 * pt) * 64 + 16 * sp;
                const v2u x0a = *(const GAS v2u*)(xp), x0b = *(const GAS v2u*)(xp + 8), x1a = *(const GAS v2u*)(xp + 32), x1b = *(const GAS v2u*)(xp + 40);
                const bf16x8 xs0 = __builtin_bit_cast(bf16x8, (v4u){x0a.x, x0a.y, x0b.x, x0b.y}), xs1 = __builtin_bit_cast(bf16x8, (v4u){x1a.x, x1a.y, x1b.x, x1b.y});
                acc[0][pt] = MFMA32(__builtin_bit_cast(bf16x8, w00), xs0, acc[0][pt]);
                acc[1][pt] = MFMA32(__builtin_bit_cast(bf16x8, w01), xs0, acc[1][pt]);
                acc[1][pt] = MFMA32(__builtin_bit_cast(bf16x8, w11), xs1, acc[1][pt]);
            }
        }
        const float Dh = d_skip_l[hd];
#pragma unroll
        for (int lt = 0; lt < 2; ++lt)
#pragma unroll
            for (int pt = 0; pt < 2; ++pt)
#pragma unroll
                for (int q4 = 0; q4 < 4; ++q4) { const v2u xv = *(const GAS v2u*)(xt + (32 * pt) * 64 + 32 * lt + 8 * q4);
                    const int l0 = 32 * lt + 8 * q4 + 4 * hh;
                    yb[(l0 + 0) * 68 + 32 * pt + r] = acc[lt][pt][4 * q4 + 0] + Dh * bflo(xv.x);
                    yb[(l0 + 1) * 68 + 32 * pt + r] = acc[lt][pt][4 * q4 + 1] + Dh * bfhi(xv.x);
                    yb[(l0 + 2) * 68 + 32 * pt + r] = acc[lt][pt][4 * q4 + 2] + Dh * bflo(xv.y);
                    yb[(l0 + 3) * 68 + 32 * pt + r] = acc[lt][pt][4 * q4 + 3] + Dh * bfhi(xv.y); }
        LDS_WAIT(); asm volatile("" ::: "memory");
        const int p8 = (lane & 7) * 8; const bf16* zp = WSB(WS_Z) + (size_t)s.row0 * DSSM + hd * 64 + p8;
#pragma unroll
        for (int it = 0; it < 8; ++it) { const int row = it * 8 + (lane >> 3);
            f32x4 y0 = *(const LAS f32x4*)(yb + row * 68 + p8), y1 = *(const LAS f32x4*)(yb + row * 68 + p8 + 4);
            v4u zr; { const unsigned zu = __builtin_bit_cast(unsigned, zf); zr = (v4u){zu, zu, zu, zu}; } if (row < s.len) zr = *(const GAS v4u*)(zp + (size_t)row * DSSM);
            y0.x *= silu(bflo(zr.x)); y0.y *= silu(bfhi(zr.x)); y0.z *= silu(bflo(zr.y)); y0.w *= silu(bfhi(zr.y));
            y1.x *= silu(bflo(zr.z)); y1.y *= silu(bfhi(zr.z)); y1.z *= silu(bflo(zr.w)); y1.w *= silu(bfhi(zr.w));
            *(LAS f32x4*)(yb + row * 68 + p8) = y0; *(LAS f32x4*)(yb + row * 68 + p8 + 4) = y1;
            float ss = (y0.x * y0.x + y0.y * y0.y) + (y0.z * y0.z + y0.w * y0.w) + (y1.x * y1.x + y1.y * y1.y) + (y1.z * y1.z + y1.w * y1.w);
            ss += shx(ss, lane, 1); ss += shx(ss, lane, 2); ss += shx(ss, lane, 4);
            if ((lane & 7) == 0) rsq[F.wave * 64 + row] = ss; }
        __syncthreads();
        const f32x4 nw0 = *(const GAS f32x4*)(ssm_norm_w_l + hd * 64 + p8), nw1 = *(const GAS f32x4*)(ssm_norm_w_l + hd * 64 + p8 + 4);
        bf16* yo = WSB(WS_Y) + (size_t)s.row0 * DM + hd * 64 + p8;
#pragma unroll
        for (int it = 0; it < 8; ++it) { const int row = it * 8 + (lane >> 3);
            float tot = 0.f;
#pragma unroll
            for (int w = 0; w < 8; ++w) tot += rsq[w * 64 + row];
            const float rstd = __builtin_amdgcn_rsqf(tot * (1.f / 512.f) + NORM_EPS);
            const f32x4 y0 = *(const LAS f32x4*)(yb + row * 68 + p8), y1 = *(const LAS f32x4*)(yb + row * 68 + p8 + 4);
            if (row < s.len) { v4u o; o.x = pk2(y0.x * rstd * nw0.x, y0.y * rstd * nw0.y); o.y = pk2(y0.z * rstd * nw0.z, y0.w * rstd * nw0.w);
                o.z = pk2(y1.x * rstd * nw1.x, y1.y * rstd * nw1.y); o.w = pk2(y1.z * rstd * nw1.z, y1.w * rstd * nw1.w);
                *(GAS v4u*)(yo + (size_t)row * DM) = o; } }
        __syncthreads();
    }
}

__device__ __forceinline__ void ssd_pass_c_prompt(Frame& F, int layer, int u0, int u1, int ustep) {
    LAS float* cumb = (LAS float*)(F.lds + SSD_SM_OFF) + F.wave * 192; LAS float* dtb = cumb + 64; LAS float* ecb = cumb + 128;
    LAS float* yb = (LAS float*)(F.lds + F.wave * SSD_YB);
    LAS float* rsq = (LAS float*)(F.lds + SSD_RS_OFF);
    const float* a_log_l = INP(15) + layer * NH; const float* d_skip_l = INP(16) + layer * NH; const float* ssm_norm_w_l = INP(17) + layer * DSSM;
#pragma unroll 1
    for (int u = u0; u < u1; u += ustep) {
        int lane = F.lane; asm volatile("" : "+v"(lane));
        const int r = lane & 31, hh = lane >> 5;
        const SsdUnit s = ssd_unit(u); const int hd = s.g * 8 + F.wave;
        const bf16* hpp = WSB(WS_ST) + (size_t)((s.b * NCH + s.c) * NH + hd) * 8192 + lane * 8;
        const bf16* xt = WSB(WS_XT) + ((size_t)s.ck * DSSM + hd * 64 + r) * 64 + 4 * hh;
        const int p8 = (lane & 7) * 8; const bf16* zp = WSB(WS_Z) + (size_t)s.row0 * DSSM + hd * 64 + p8;
        LAS unsigned char* ctl = F.lds; LAS unsigned char* btl = F.lds + SSD_YB;
        const int q0 = F.wave * 64 + lane;
        v4u sc[2], sb[2];
#pragma unroll
        for (int j = 0; j < 2; ++j) { const int q = q0 + 512 * j; const size_t go = (size_t)(s.row0 + (q >> 4)) * GB + s.g * DST + (q & 15) * 8;
            sc[j] = *(const GAS v4u*)(WSB(WS_CTOK) + go); sb[j] = *(const GAS v4u*)(WSB(WS_BTOK) + go); }
        bf16x8 hf[8][2];
#pragma unroll
        for (int ks = 0; ks < 8; ++ks)
#pragma unroll
            for (int t = 0; t < 2; ++t) hf[ks][t] = *(const GAS bf16x8*)(hpp + (2 * ks + t) * 512);
        __builtin_amdgcn_sched_barrier(0);
        float dtv, cum, cl; ssd_dt_cum_l(F, a_log_l, s, hd, lane, dtv, cum, cl);
        cumb[lane] = cum; dtb[lane] = dtv; ecb[lane] = fexp(cum);
#pragma unroll
        for (int j = 0; j < 2; ++j) { const int q = q0 + 512 * j; *(LAS v4u*)(ctl + (q >> 4) * 272 + (q & 15) * 16) = sc[j]; *(LAS v4u*)(btl + (q >> 4) * 272 + (q & 15) * 16) = sb[j]; }
        LDS_WAIT(); __builtin_amdgcn_s_barrier(); asm volatile("" ::: "memory");
        const f32x16 z16 = {0.f, 0.f, 0.f, 0.f, 0.f, 0.f, 0.f, 0.f, 0.f, 0.f, 0.f, 0.f, 0.f, 0.f, 0.f, 0.f};
        f32x16 T00, T01, T11, acc[2][2];
        const LAS unsigned char* cfr = ctl + r * 272 + 16 * hh; const LAS unsigned char* bfr = btl + r * 272 + 16 * hh;
#pragma unroll
        for (int ks = 0; ks < 8; ++ks) {
            const bf16x8 c0 = *(const LAS bf16x8*)(cfr + 32 * ks), c1 = *(const LAS bf16x8*)(cfr + 32 * 272 + 32 * ks), g0 = *(const LAS bf16x8*)(bfr + 32 * ks), g1 = *(const LAS bf16x8*)(bfr + 32 * 272 + 32 * ks);
            if (ks == 0) { T00 = MFMA32(g0, c0, z16); T01 = MFMA32(g0, c1, z16); T11 = MFMA32(g1, c1, z16);
                acc[0][0] = MFMA32(c0, hf[0][0], z16); acc[0][1] = MFMA32(c0, hf[0][1], z16); acc[1][0] = MFMA32(c1, hf[0][0], z16); acc[1][1] = MFMA32(c1, hf[0][1], z16); }
            else { T00 = MFMA32(g0, c0, T00); T01 = MFMA32(g0, c1, T01); T11 = MFMA32(g1, c1, T11);
                acc[0][0] = MFMA32(c0, hf[ks][0], acc[0][0]); acc[0][1] = MFMA32(c0, hf[ks][1], acc[0][1]); acc[1][0] = MFMA32(c1, hf[ks][0], acc[1][0]); acc[1][1] = MFMA32(c1, hf[ks][1], acc[1][1]); }
        }
        __builtin_amdgcn_sched_barrier(0);
        v2u xv[2][2][4]; v4u zr[8];
#pragma unroll
        for (int pt = 0; pt < 2; ++pt)
#pragma unroll
            for (int lt = 0; lt < 2; ++lt)
#pragma unroll
                for (int q4 = 0; q4 < 4; ++q4) xv[pt][lt][q4] = *(const GAS v2u*)(xt + (32 * pt) * 64 + 32 * lt + 8 * q4);
        LDS_WAIT(); __builtin_amdgcn_s_barrier(); asm volatile("" ::: "memory");
        const float cl0 = cumb[r], cl1 = cumb[32 + r];
#pragma unroll
        for (int q4 = 0; q4 < 4; ++q4) { const int s0 = 8 * q4 + 4 * hh;
            const f32x4 cs0v = *(const LAS f32x4*)(cumb + s0), cs1v = *(const LAS f32x4*)(cumb + 32 + s0), d0v = *(const LAS f32x4*)(dtb + s0), d1v = *(const LAS f32x4*)(dtb + 32 + s0);
#pragma unroll
            for (int j = 0; j < 4; ++j) { const int e = 4 * q4 + j, si = s0 + j;
                T00[e] = (si <= r) ? T00[e] * fexp(fminf(cl0 - cs0v[j], 0.f)) * d0v[j] : 0.f;
                T01[e] = T01[e] * fexp(fminf(cl1 - cs0v[j], 0.f)) * d0v[j];
                T11[e] = (si <= r) ? T11[e] * fexp(fminf(cl1 - cs1v[j], 0.f)) * d1v[j] : 0.f; } }
        v4u w00[2], w01[2], w11[2];
#pragma unroll
        for (int sp = 0; sp < 2; ++sp) {
            w00[sp].x = pk2(T00[8 * sp + 0], T00[8 * sp + 1]); w00[sp].y = pk2(T00[8 * sp + 2], T00[8 * sp + 3]); w00[sp].z = pk2(T00[8 * sp + 4], T00[8 * sp + 5]); w00[sp].w = pk2(T00[8 * sp + 6], T00[8 * sp + 7]);
            w01[sp].x = pk2(T01[8 * sp + 0], T01[8 * sp + 1]); w01[sp].y = pk2(T01[8 * sp + 2], T01[8 * sp + 3]); w01[sp].z = pk2(T01[8 * sp + 4], T01[8 * sp + 5]); w01[sp].w = pk2(T01[8 * sp + 6], T01[8 * sp + 7]);
            w11[sp].x = pk2(T11[8 * sp + 0], T11[8 * sp + 1]); w11[sp].y = pk2(T11[8 * sp + 2], T11[8 * sp + 3]); w11[sp].z = pk2(T11[8 * sp + 4], T11[8 * sp + 5]); w11[sp].w = pk2(T11[8 * sp + 6], T11[8 * sp + 7]); }
        __builtin_amdgcn_sched_barrier(0);
#pragma unroll
        for (int it = 0; it < 8; ++it) zr[it] = *(const GAS v4u*)(zp + (size_t)(it * 8 + (lane >> 3)) * DSSM);
        __builtin_amdgcn_sched_barrier(0);
#pragma unroll
        for (int lt = 0; lt < 2; ++lt)
#pragma unroll
            for (int q4 = 0; q4 < 4; ++q4) { const f32x4 sc4 = *(const LAS f32x4*)(ecb + 32 * lt + 8 * q4 + 4 * hh);
#pragma unroll
                for (int j = 0; j < 4; ++j) { acc[lt][0][4 * q4 + j] *= sc4[j]; acc[lt][1][4 * q4 + j] *= sc4[j]; } }
#pragma unroll
        for (int sp = 0; sp < 2; ++sp) {
#pragma unroll
            for (int pt = 0; pt < 2; ++pt) {
                const v2u x0a = xv[pt][0][2 * sp], x0b = xv[pt][0][2 * sp + 1], x1a = xv[pt][1][2 * sp], x1b = xv[pt][1][2 * sp + 1];
                const bf16x8 xs0 = __builtin_bit_cast(bf16x8, (v4u){x0a.x, x0a.y, x0b.x, x0b.y}), xs1 = __builtin_bit_cast(bf16x8, (v4u){x1a.x, x1a.y, x1b.x, x1b.y});
                acc[0][pt] = MFMA32(__builtin_bit_cast(bf16x8, w00[sp]), xs0, acc[0][pt]);
                acc[1][pt] = MFMA32(__builtin_bit_cast(bf16x8, w01[sp]), xs0, acc[1][pt]);
                acc[1][pt] = MFMA32(__builtin_bit_cast(bf16x8, w11[sp]), xs1, acc[1][pt]);
            }
        }
        const float Dh = d_skip_l[hd];
#pragma unroll
        for (int lt = 0; lt < 2; ++lt)
#pragma unroll
            for (int pt = 0; pt < 2; ++pt)
#pragma unroll
                for (int q4 = 0; q4 < 4; ++q4) { const v2u xq = xv[pt][lt][q4];
                    const int l0 = 32 * lt + 8 * q4 + 4 * hh;
                    yb[(l0 + 0) * 68 + 32 * pt + r] = acc[lt][pt][4 * q4 + 0] + Dh * bflo(xq.x);
                    yb[(l0 + 1) * 68 + 32 * pt + r] = acc[lt][pt][4 * q4 + 1] + Dh * bfhi(xq.x);
                    yb[(l0 + 2) * 68 + 32 * pt + r] = acc[lt][pt][4 * q4 + 2] + Dh * bflo(xq.y);
                    yb[(l0 + 3) * 68 + 32 * pt + r] = acc[lt][pt][4 * q4 + 3] + Dh * bfhi(xq.y); }
        LDS_WAIT(); asm volatile("" ::: "memory");
#pragma unroll
        for (int it = 0; it < 8; ++it) { const int row = it * 8 + (lane >> 3);
            f32x4 y0 = *(const LAS f32x4*)(yb + row * 68 + p8), y1 = *(const LAS f32x4*)(yb + row * 68 + p8 + 4);
            const v4u zq = zr[it];
            y0.x *= silu(bflo(zq.x)); y0.y *= silu(bfhi(zq.x)); y0.z *= silu(bflo(zq.y)); y0.w *= silu(bfhi(zq.y));
            y1.x *= silu(bflo(zq.z)); y1.y *= silu(bfhi(zq.z)); y1.z *= silu(bflo(zq.w)); y1.w *= silu(bfhi(zq.w));
            *(LAS f32x4*)(yb + row * 68 + p8) = y0; *(LAS f32x4*)(yb + row * 68 + p8 + 4) = y1;
            float ss = (y0.x * y0.x + y0.y * y0.y) + (y0.z * y0.z + y0.w * y0.w) + (y1.x * y1.x + y1.y * y1.y) + (y1.z * y1.z + y1.w * y1.w);
            ss += shx(ss, lane, 1); ss += shx(ss, lane, 2); ss += shx(ss, lane, 4);
            if ((lane & 7) == 0) rsq[F.wave * 64 + row] = ss; }
        __syncthreads();
        const f32x4 nw0 = *(const GAS f32x4*)(ssm_norm_w_l + hd * 64 + p8), nw1 = *(const GAS f32x4*)(ssm_norm_w_l + hd * 64 + p8 + 4);
        bf16* yo = WSB(WS_Y) + (size_t)s.row0 * DM + hd * 64 + p8;
#pragma unroll
        for (int it = 0; it < 8; ++it) { const int row = it * 8 + (lane >> 3);
            float tot = 0.f;
#pragma unroll
            for (int w = 0; w < 8; ++w) tot += rsq[w * 64 + row];
            const float rstd = __builtin_amdgcn_rsqf(tot * (1.f / 512.f) + NORM_EPS);
            const f32x4 y0 = *(const LAS f32x4*)(yb + row * 68 + p8), y1 = *(const LAS f32x4*)(yb + row * 68 + p8 + 4);
            v4u o; o.x = pk2(y0.x * rstd * nw0.x, y0.y * rstd * nw0.y); o.y = pk2(y0.z * rstd * nw0.z, y0.w * rstd * nw0.w);
            o.z = pk2(y1.x * rstd * nw1.x, y1.y * rstd * nw1.y); o.w = pk2(y1.z * rstd * nw1.z, y1.w * rstd * nw1.w);
            *(GAS v4u*)(yo + (size_t)row * DM) = o; }
        __syncthreads();
    }
}

#define MFMA16(a, b, c) __builtin_amdgcn_mfma_f32_16x16x32_bf16((a), (b), (c), 0, 0, 0)
typedef short v4i16_t __attribute__((ext_vector_type(4)));
__device__ __forceinline__ s16x4 vtr(const LAS unsigned char* p) { return __builtin_bit_cast(s16x4, __builtin_amdgcn_ds_read_tr16_b64_v4i16((LAS v4i16_t*)p)); }
__device__ __forceinline__ void swap32(float& a, float& b) { asm volatile("s_nop 1\n\tv_permlane32_swap_b32 %0, %1" : "+v"(a), "+v"(b)); }
__device__ __forceinline__ void swap16(float& a, float& b) { asm volatile("s_nop 1\n\tv_permlane16_swap_b32 %0, %1" : "+v"(a), "+v"(b)); }
__device__ __forceinline__ float swap32_max(float v) { float a = v, b = v; swap32(a, b); return fmaxf(a, b); }
__device__ __forceinline__ float swap32_sum(float v) { float a = v, b = v; swap32(a, b); return a + b; }
__device__ __forceinline__ float swap16_max(float v) { float a = v, b = v; swap16(a, b); return fmaxf(a, b); }
constexpr int AT_QS = 528, AT_KS = 528, AT_VS = 544;
constexpr int AT_Q0 = 0, AT_K0 = 128 * AT_QS, AT_KB = 32 * AT_KS, AT_V0 = AT_K0 + 2 * AT_KB, AT_VB = 32 * AT_VS;
static_assert(AT_V0 + 2 * AT_VB <= RING_BYTES, "attention LDS map");
struct AttnUnit { const bf16* Q; const bf16* K; const bf16* V; const bf16* Gt; bf16* Yo; int nq, ntiles, nvis_lo, nvis_hi, lk; };

template <bool DIFF>
__device__ __forceinline__ void attn_unit(Frame& F, const AttnUnit& U, float lam, float osc, const float* subw, float sc) {
    constexpr int NMAP = DIFF ? 2 : 1, NKS = DIFF ? 4 : 8;
    int lane = F.lane; asm volatile("" : "+v"(lane));
    const int w = F.wave, tid = w * 64 + lane, q16 = lane & 15, g = lane >> 4;
    LAS unsigned char* L = F.lds;
    const float zf = zero_asm();
#pragma unroll 1
    for (int ci = tid; ci < U.nq * 32; ci += NWAVES * 64) { const int row = ci >> 5, ch = ci & 31; *(LAS v4u*)(L + AT_Q0 + row * AT_QS + ch * 16) = *(const GAS v4u*)(U.Q + (size_t)row * 1024 + ch * 8); }
    const int r0 = tid >> 5, ch = tid & 31;
    v4u kr0, kr1, vr0, vr1;
    { const bf16* kp = U.K + (size_t)r0 * 1024 + ch * 8; const bf16* vp = U.V + (size_t)r0 * 1024 + ch * 8;
      kr0 = *(const GAS v4u*)kp; kr1 = *(const GAS v4u*)(kp + 16 * 1024); vr0 = *(const GAS v4u*)vp; vr1 = *(const GAS v4u*)(vp + 16 * 1024); }
    *(LAS v4u*)(L + AT_K0 + r0 * AT_KS + ch * 16) = kr0; *(LAS v4u*)(L + AT_K0 + (r0 + 16) * AT_KS + ch * 16) = kr1;
    *(LAS v4u*)(L + AT_V0 + r0 * AT_VS + ch * 16) = vr0; *(LAS v4u*)(L + AT_V0 + (r0 + 16) * AT_VS + ch * 16) = vr1;
    __syncthreads();
    const bool active = (16 * w) < U.nq;
    const int nvis = (w < 4) ? U.nvis_lo : U.nvis_hi;
    f32x4 O[NMAP][16];
#pragma unroll
    for (int m = 0; m < NMAP; ++m)
#pragma unroll
        for (int nt = 0; nt < 16; ++nt) O[m][nt] = (f32x4){zf, zf, zf, zf};
    float mrun[NMAP], lsum[NMAP];
#pragma unroll
    for (int m = 0; m < NMAP; ++m) { mrun[m] = -INFINITY; lsum[m] = zf; }
    const LAS unsigned char* Qb = L + AT_Q0 + (16 * w + q16) * AT_QS + 16 * g;
    const int kvoff = q16 * AT_KS + 16 * g;
    const int vtoff = (4 * g + (q16 >> 2)) * AT_VS + 8 * (lane & 3);
#pragma unroll 1
    for (int t = 0; t < U.ntiles; ++t) {
        const bool more = (t + 1) < U.ntiles;
        if (more) { const bf16* kp = U.K + (size_t)(32 * (t + 1) + r0) * 1024 + ch * 8; const bf16* vp = U.V + (size_t)(32 * (t + 1) + r0) * 1024 + ch * 8;
            kr0 = *(const GAS v4u*)kp; kr1 = *(const GAS v4u*)(kp + 16 * 1024); vr0 = *(const GAS v4u*)vp; vr1 = *(const GAS v4u*)(vp + 16 * 1024); }
        if (active && t < nvis) {
            const LAS unsigned char* Kb = L + AT_K0 + (t & 1) * AT_KB + kvoff; const LAS unsigned char* Vb = L + AT_V0 + (t & 1) * AT_VB + vtoff;
            f32x4 s[NMAP][2];
#pragma unroll
            for (int m = 0; m < NMAP; ++m) { s[m][0] = (f32x4){zf, zf, zf, zf}; s[m][1] = (f32x4){zf, zf, zf, zf}; }
            bf16x8 qA, kA0, kA1, qB, kB0, kB1;
#define AT_LDS(st, q, k0, k1) do { q = *(const LAS bf16x8*)(Qb + 64 * (st)); k0 = *(const LAS bf16x8*)(Kb + 64 * (st)); k1 = *(const LAS bf16x8*)(Kb + 16 * AT_KS + 64 * (st)); } while (0)
            AT_LDS(0, qA, kA0, kA1); AT_LDS(1, qB, kB0, kB1);
#pragma unroll
            for (int st = 0; st < 8; ++st) { const int m = DIFF ? (st >> 2) : 0;
                if ((st & 1) == 0) { s[m][0] = MFMA16(kA0, qA, s[m][0]); s[m][1] = MFMA16(kA1, qA, s[m][1]); if (st + 2 < 8) AT_LDS(st + 2, qA, kA0, kA1); }
                else { s[m][0] = MFMA16(kB0, qB, s[m][0]); s[m][1] = MFMA16(kB1, qB, s[m][1]); if (st + 2 < 8) AT_LDS(st + 2, qB, kB0, kB1); }
                __builtin_amdgcn_sched_barrier(0); }
#undef AT_LDS
            s16x4 vA0 = vtr(Vb), vA1 = vtr(Vb + 16 * AT_VS), vB0 = vtr(Vb + 32), vB1 = vtr(Vb + 16 * AT_VS + 32);
            bf16x8 pf[NMAP];
            const bool tail = (32 * t + 32) > U.lk;
#pragma unroll
            for (int m = 0; m < NMAP; ++m) {
                float p[8];
#pragma unroll
                for (int sub = 0; sub < 2; ++sub)
#pragma unroll
                    for (int e = 0; e < 4; ++e) p[4 * sub + e] = s[m][sub][e];
                if (tail) {
#pragma unroll
                    for (int sub = 0; sub < 2; ++sub)
#pragma unroll
                        for (int e = 0; e < 4; ++e) if (32 * t + 16 * sub + 4 * g + e >= U.lk) p[4 * sub + e] = -INFINITY;
                }
                float mx = fmaxf(fmaxf(fmaxf(p[0], p[1]), fmaxf(p[2], p[3])), fmaxf(fmaxf(p[4], p[5]), fmaxf(p[6], p[7])));
                mx = swap32_max(swap16_max(mx));
                mx *= sc;
                const float mn = fmaxf(mrun[m], mx); const float mref = (mn == -INFINITY) ? 0.f : mn;
                float ps = 0.f;
#pragma unroll
                for (int k = 0; k < 8; ++k) { p[k] = ex2(__builtin_fmaf(p[k], sc, -mref)); ps += p[k]; }
                if (!__all(mn == mrun[m])) {
                    const float alpha = ex2(mrun[m] - mref);
                    lsum[m] *= alpha;
#pragma unroll
                    for (int nt = 0; nt < 16; ++nt) O[m][nt] = O[m][nt] * alpha;
                }
                lsum[m] += ps; mrun[m] = mn;
                v4u pk; pk.x = pk2(p[0], p[1]); pk.y = pk2(p[2], p[3]); pk.z = pk2(p[4], p[5]); pk.w = pk2(p[6], p[7]); pf[m] = __builtin_bit_cast(bf16x8, pk);
            }
            __builtin_amdgcn_sched_barrier(0);
#pragma unroll
            for (int nt = 0; nt < 16; ++nt) {
                if ((nt & 1) == 0) { const bf16x8 vf = (bf16x8){vA0[0], vA0[1], vA0[2], vA0[3], vA1[0], vA1[1], vA1[2], vA1[3]};
#pragma unroll
                    for (int m = 0; m < NMAP; ++m) O[m][nt] = MFMA16(vf, pf[m], O[m][nt]);
                    if (nt + 2 < 16) { vA0 = vtr(Vb + 32 * (nt + 2)); vA1 = vtr(Vb + 16 * AT_VS + 32 * (nt + 2)); } }
                else { const bf16x8 vf = (bf16x8){vB0[0], vB0[1], vB0[2], vB0[3], vB1[0], vB1[1], vB1[2], vB1[3]};
#pragma unroll
                    for (int m = 0; m < NMAP; ++m) O[m][nt] = MFMA16(vf, pf[m], O[m][nt]);
                    if (nt + 2 < 16) { vB0 = vtr(Vb + 32 * (nt + 2)); vB1 = vtr(Vb + 16 * AT_VS + 32 * (nt + 2)); } }
                __builtin_amdgcn_sched_barrier(0);
            }
        }
        if (more) { const int bo = ((t + 1) & 1);
            *(LAS v4u*)(L + AT_K0 + bo * AT_KB + r0 * AT_KS + ch * 16) = kr0; *(LAS v4u*)(L + AT_K0 + bo * AT_KB + (r0 + 16) * AT_KS + ch * 16) = kr1;
            *(LAS v4u*)(L + AT_V0 + bo * AT_VB + r0 * AT_VS + ch * 16) = vr0; *(LAS v4u*)(L + AT_V0 + bo * AT_VB + (r0 + 16) * AT_VS + ch * 16) = vr1; }
        __syncthreads();
    }
    if (active) {
        float inv[NMAP];
#pragma unroll
        for (int m = 0; m < NMAP; ++m) { float l = lsum[m]; l += shx(l, lane, 16); l += shx(l, lane, 32); inv[m] = __builtin_amdgcn_rcpf(l); }
        LAS unsigned char* T = L + w * 8448;
        if constexpr (DIFF) {
            float ss = 0.f;
#pragma unroll
            for (int nt = 0; nt < 16; ++nt)
#pragma unroll
                for (int e = 0; e < 4; ++e) { const float o = O[0][nt][e] * inv[0] - lam * (O[1][nt][e] * inv[1]); O[0][nt][e] = o; ss += o * o; }
            ss += shx(ss, lane, 16); ss += shx(ss, lane, 32);
            const float rstd = osc * __builtin_amdgcn_rsqf(ss * (1.f / 256.f) + SUBLN_EPS);
#pragma unroll
            for (int nt = 0; nt < 16; ++nt) { const int d0 = 16 * nt + 4 * g; const f32x4 sw = *(const GAS f32x4*)(subw + d0);
                v2u o; o.x = pk2(O[0][nt][0] * rstd * sw.x, O[0][nt][1] * rstd * sw.y); o.y = pk2(O[0][nt][2] * rstd * sw.z, O[0][nt][3] * rstd * sw.w);
                *(LAS v2u*)(T + q16 * 528 + d0 * 2) = o; }
        } else {
#pragma unroll
            for (int nt = 0; nt < 16; ++nt) { const int d0 = 16 * nt + 4 * g;
                v2u o; o.x = pk2(O[0][nt][0] * inv[0], O[0][nt][1] * inv[0]); o.y = pk2(O[0][nt][2] * inv[0], O[0][nt][3] * inv[0]);
                *(LAS v2u*)(T + q16 * 528 + d0 * 2) = o; }
        }
        LDS_WAIT(); asm volatile("" ::: "memory");
        const int le = lane_id_asm(), rr = le >> 5, cc = (le & 31) * 8;
        v4u gt[8];
#pragma unroll
        for (int it = 0; it < 8; ++it) gt[it] = *(const GAS v4u*)(U.Gt + (size_t)(16 * w + 2 * it + rr) * 1024 + cc);
#pragma unroll
        for (int it = 0; it < 8; ++it) { const v4u y = *(const LAS v4u*)(T + (2 * it + rr) * 528 + cc * 2); const v4u gq = gt[it]; v4u o;
            o.x = pk2(bflo(y.x) * silu(bflo(gq.x)), bfhi(y.x) * silu(bfhi(gq.x))); o.y = pk2(bflo(y.y) * silu(bflo(gq.y)), bfhi(y.y) * silu(bfhi(gq.y)));
            o.z = pk2(bflo(y.z) * silu(bflo(gq.z)), bfhi(y.z) * silu(bfhi(gq.z))); o.w = pk2(bflo(y.w) * silu(bflo(gq.w)), bfhi(y.w) * silu(bfhi(gq.w)));
            *(GAS v4u*)(U.Yo + (size_t)(16 * w + 2 * it + rr) * DM + cc) = o; }
    }
}

constexpr int AB_KS = 528, AB_VS = 576, AB_KB = 32 * AB_KS, AB_K0 = 0, AB_V0 = 2 * AB_KB, AB_VB = 32 * AB_VS;
static_assert(AB_V0 + 2 * AB_VB <= RING_BYTES && 4 * 32768 <= RING_BYTES, "attention (32x32) LDS map");
__device__ __forceinline__ void attn_unit_b(Frame& F, const AttnUnit& U, float lam, float osc, const float* subw, float sc) {
    int lane = F.lane; asm volatile("" : "+v"(lane));
    const int w = F.wave, tid = w * 64 + lane, r = lane & 31, hh = lane >> 5, qg = w & 3, m = w >> 2;
    LAS unsigned char* L = F.lds;
    const float zf = zero_asm();
    bf16x8 qf[8];
    { const bf16* qp = U.Q + (size_t)(32 * qg + r) * 1024 + 128 * m + 8 * hh;
#pragma unroll
      for (int ks = 0; ks < 8; ++ks) qf[ks] = *(const GAS bf16x8*)(qp + 16 * ks);
#pragma unroll
      for (int ks = 0; ks < 8; ++ks) asm volatile("" : "+v"(qf[ks])); }
    const int r0 = tid >> 5, ch = tid & 31;
    v4u kr0, kr1, vr0, vr1;
    { const bf16* kp = U.K + (size_t)r0 * 1024 + ch * 8; const bf16* vp = U.V + (size_t)r0 * 1024 + ch * 8;
      kr0 = *(const GAS v4u*)kp; kr1 = *(const GAS v4u*)(kp + 16 * 1024); vr0 = *(const GAS v4u*)vp; vr1 = *(const GAS v4u*)(vp + 16 * 1024); }
    *(LAS v4u*)(L + AB_K0 + r0 * AB_KS + ch * 16) = kr0; *(LAS v4u*)(L + AB_K0 + (r0 + 16) * AB_KS + ch * 16) = kr1;
    *(LAS v4u*)(L + AB_V0 + r0 * AB_VS + ch * 16) = vr0; *(LAS v4u*)(L + AB_V0 + (r0 + 16) * AB_VS + ch * 16) = vr1;
    __syncthreads();
    const int nvis = (qg < 2) ? U.nvis_lo : U.nvis_hi;
    f32x16 O[8];
#pragma unroll
    for (int dt = 0; dt < 8; ++dt)
#pragma unroll
        for (int e = 0; e < 16; ++e) O[dt][e] = zf;
    float mrun = -INFINITY, lsum = zf;
    const int koff = r * AB_KS + (128 * m + 8 * hh) * 2;
    const int voff = (4 * hh + ((lane & 15) >> 2)) * AB_VS + (16 * ((lane >> 4) & 1) + 4 * (lane & 3)) * 2;
#pragma unroll 1
    for (int t = 0; t < U.ntiles; ++t) {
        const bool more = (t + 1) < U.ntiles;
        if (more) { const bf16* kp = U.K + (size_t)(32 * (t + 1) + r0) * 1024 + ch * 8; const bf16* vp = U.V + (size_t)(32 * (t + 1) + r0) * 1024 + ch * 8;
            kr0 = *(const GAS v4u*)kp; kr1 = *(const GAS v4u*)(kp + 16 * 1024); vr0 = *(const GAS v4u*)vp; vr1 = *(const GAS v4u*)(vp + 16 * 1024); }
        if (t < nvis) {
            const LAS unsigned char* Kb = L + AB_K0 + (t & 1) * AB_KB + koff; const LAS unsigned char* Vb = L + AB_V0 + (t & 1) * AB_VB + voff;
            f32x16 s;
#pragma unroll
            for (int e = 0; e < 16; ++e) s[e] = zf;
            bf16x8 kA = *(const LAS bf16x8*)(Kb), kB = *(const LAS bf16x8*)(Kb + 32);
#pragma unroll
            for (int ks = 0; ks < 8; ++ks) {
                if ((ks & 1) == 0) { s = MFMA32(kA, qf[ks], s); if (ks + 2 < 8) kA = *(const LAS bf16x8*)(Kb + 32 * (ks + 2)); }
                else { s = MFMA32(kB, qf[ks], s); if (ks + 2 < 8) kB = *(const LAS bf16x8*)(Kb + 32 * (ks + 2)); }
                __builtin_amdgcn_sched_barrier(0); }
#define AB_VF(idx, a0, a1) do { a0 = vtr(Vb + (16 * ((idx) >> 3)) * AB_VS + 64 * ((idx) & 7)); a1 = vtr(Vb + (16 * ((idx) >> 3) + 8) * AB_VS + 64 * ((idx) & 7)); } while (0)
            s16x4 vA0, vA1, vB0, vB1; AB_VF(0, vA0, vA1); AB_VF(1, vB0, vB1);
            float mx = fmaxf(fmaxf(fmaxf(s[0], s[1]), fmaxf(s[2], s[3])), fmaxf(fmaxf(s[4], s[5]), fmaxf(s[6], s[7])));
            mx = fmaxf(mx, fmaxf(fmaxf(fmaxf(s[8], s[9]), fmaxf(s[10], s[11])), fmaxf(fmaxf(s[12], s[13]), fmaxf(s[14], s[15]))));
            mx = swap32_max(mx);
            mx *= sc;
            if (!__all(mx <= mrun + 8.f)) {
                const float mn = fmaxf(mrun, mx), alpha = ex2(mrun - mn);
                lsum *= alpha;
#pragma unroll
                for (int dt = 0; dt < 8; ++dt)
#pragma unroll
                    for (int e = 0; e < 16; ++e) O[dt][e] *= alpha;
                mrun = mn;
            }
            float ps = 0.f;
#pragma unroll
            for (int e = 0; e < 16; ++e) { s[e] = ex2(__builtin_fmaf(s[e], sc, -mrun)); ps += s[e]; }
            lsum += ps;
            bf16x8 pf[2];
#pragma unroll
            for (int sp = 0; sp < 2; ++sp) { v4u pk; pk.x = pk2(s[8 * sp], s[8 * sp + 1]); pk.y = pk2(s[8 * sp + 2], s[8 * sp + 3]); pk.z = pk2(s[8 * sp + 4], s[8 * sp + 5]); pk.w = pk2(s[8 * sp + 6], s[8 * sp + 7]); pf[sp] = __builtin_bit_cast(bf16x8, pk); }
            __builtin_amdgcn_sched_barrier(0);
#pragma unroll
            for (int idx = 0; idx < 16; ++idx) {
                if ((idx & 1) == 0) { const bf16x8 vf = (bf16x8){vA0[0], vA0[1], vA0[2], vA0[3], vA1[0], vA1[1], vA1[2], vA1[3]};
                    O[idx & 7] = MFMA32(vf, pf[idx >> 3], O[idx & 7]); if (idx + 2 < 16) AB_VF(idx + 2, vA0, vA1); }
                else { const bf16x8 vf = (bf16x8){vB0[0], vB0[1], vB0[2], vB0[3], vB1[0], vB1[1], vB1[2], vB1[3]};
                    O[idx & 7] = MFMA32(vf, pf[idx >> 3], O[idx & 7]); if (idx + 2 < 16) AB_VF(idx + 2, vB0, vB1); }
                __builtin_amdgcn_sched_barrier(0);
            }
#undef AB_VF
        }
        if (more) { const int bo = ((t + 1) & 1);
            *(LAS v4u*)(L + AB_K0 + bo * AB_KB + r0 * AB_KS + ch * 16) = kr0; *(LAS v4u*)(L + AB_K0 + bo * AB_KB + (r0 + 16) * AB_KS + ch * 16) = kr1;
            *(LAS v4u*)(L + AB_V0 + bo * AB_VB + r0 * AB_VS + ch * 16) = vr0; *(LAS v4u*)(L + AB_V0 + bo * AB_VB + (r0 + 16) * AB_VS + ch * 16) = vr1; }
        __syncthreads();
    }
    const float l = swap32_sum(lsum);
    LAS unsigned char* X = L + qg * 32768 + lane * 16;
    if (m == 1) { const float sc2 = lam * __builtin_amdgcn_rcpf(l);
#pragma unroll
        for (int dt = 0; dt < 8; ++dt)
#pragma unroll
            for (int q4 = 0; q4 < 4; ++q4) *(LAS f32x4*)(X + dt * 4096 + q4 * 1024) = (f32x4){O[dt][4 * q4] * sc2, O[dt][4 * q4 + 1] * sc2, O[dt][4 * q4 + 2] * sc2, O[dt][4 * q4 + 3] * sc2}; }
    __syncthreads();
    float ss = 0.f;
    if (m == 0) { const float inv = __builtin_amdgcn_rcpf(l);
#pragma unroll
        for (int dt = 0; dt < 8; ++dt)
#pragma unroll
            for (int q4 = 0; q4 < 4; ++q4) { const f32x4 x2 = *(const LAS f32x4*)(X + dt * 4096 + q4 * 1024);
#pragma unroll
                for (int e = 0; e < 4; ++e) { const float o = O[dt][4 * q4 + e] * inv - x2[e]; O[dt][4 * q4 + e] = o; ss += o * o; } } }
    __syncthreads();
    if (m == 0) {
        ss = swap32_sum(ss);
        const float rstd = osc * __builtin_amdgcn_rsqf(ss * (1.f / 256.f) + SUBLN_EPS);
        LAS unsigned char* T = L + 70656 + qg * 16896;
#pragma unroll
        for (int dt = 0; dt < 8; ++dt)
#pragma unroll
            for (int q4 = 0; q4 < 4; ++q4) { const int d0 = 32 * dt + 8 * q4 + 4 * hh; const f32x4 sw = *(const GAS f32x4*)(subw + d0);
                v2u o; o.x = pk2(O[dt][4 * q4] * rstd * sw.x, O[dt][4 * q4 + 1] * rstd * sw.y); o.y = pk2(O[dt][4 * q4 + 2] * rstd * sw.z, O[dt][4 * q4 + 3] * rstd * sw.w);
                *(LAS v2u*)(T + r * 528 + d0 * 2) = o; }
        LDS_WAIT(); asm volatile("" ::: "memory");
        const int le = lane_id_asm(), rr = le >> 5, cc = (le & 31) * 8;
#pragma unroll
        for (int h8 = 0; h8 < 2; ++h8) {
        v4u gt[8];
#pragma unroll
        for (int i8 = 0; i8 < 8; ++i8) gt[i8] = *(const GAS v4u*)(U.Gt + (size_t)(32 * qg + 2 * (8 * h8 + i8) + rr) * 1024 + cc);
#pragma unroll
        for (int i8 = 0; i8 < 8; ++i8) { const int it = 8 * h8 + i8; const v4u y = *(const LAS v4u*)(T + (2 * it + rr) * 528 + cc * 2); const v4u g = gt[i8]; v4u o;
            o.x = pk2(bflo(y.x) * silu(bflo(g.x)), bfhi(y.x) * silu(bfhi(g.x))); o.y = pk2(bflo(y.y) * silu(bflo(g.y)), bfhi(y.y) * silu(bfhi(g.y)));
            o.z = pk2(bflo(y.z) * silu(bflo(g.z)), bfhi(y.z) * silu(bfhi(g.z))); o.w = pk2(bflo(y.w) * silu(bflo(g.w)), bfhi(y.w) * silu(bfhi(g.w)));
            *(GAS v4u*)(U.Yo + (size_t)(32 * qg + 2 * it + rr) * DM + cc) = o; }
        __builtin_amdgcn_sched_barrier(0); }
    }
}

__device__ __forceinline__ void attn_queue(Frame& F, int layer, unsigned* qcnt, const int x, unsigned* pbd, const unsigned nssd) {
    const float lambda_init = layer == 0 ? 0.2f : 0.35550906759096926f;
    float d1 = 0.f, d2 = 0.f;
    { const int i = F.lane * 2; const float* a = INP(18  ) + layer * 128; const float* b = INP(19  ) + layer * 128; const float* c = INP(20  ) + layer * 128; const float* d = INP(21  ) + layer * 128;
      d1 = a[i] * b[i] + a[i + 1] * b[i + 1]; d2 = c[i] * d[i] + c[i + 1] * d[i + 1]; }
    d1 = wave_sum(d1, F.lane); d2 = wave_sum(d2, F.lane);
    const int lam_s = __builtin_amdgcn_readfirstlane(__builtin_bit_cast(int, __expf(d1) - __expf(d2) + lambda_init));
    const float* subw = INP(22  ) + layer * 256;
    const float scd = 0.08838834764831845f * 1.4426950408889634f, scm = 0.0625f * 1.4426950408889634f;
    bool scan_seen = false;
    unsigned nxt = 0u; int slot = 0;
    if (F.tid == 0) { nxt = xb_add(qcnt, 1u); F.MISC[16] = nxt; }
#define AQ_TOP()    do { __syncthreads(); idx = __builtin_amdgcn_readfirstlane((int)F.MISC[16 + slot]); } while (0)
#define AQ_ISSUE()  do { if (F.tid == 0) nxt = xb_add(qcnt, 1u); } while (0)
#define AQ_BOTTOM() do { slot ^= 1; if (F.tid == 0) F.MISC[16 + slot] = nxt; } while (0)
    int idx; AQ_TOP();
#pragma unroll 1
    while (idx < 64) {
        AQ_ISSUE();
        { float lam = __builtin_bit_cast(float, lam_s); asm volatile("" : "+v"(lam));
          AttnUnit U; const int qt = 31 - (idx >> 1), bh = 2 * x + (idx & 1), b = bh >> 2, h = bh & 3; const size_t row = (size_t)b * SEQ + 128 * qt;
          U.Q = WSB(WS_QD) + row * 1024 + h * 256; U.K = WSB(WS_KD) + (size_t)b * SEQ * 1024 + h * 256; U.V = WSB(WS_VD) + (size_t)b * SEQ * 1024 + h * 256;
          U.Gt = WSB(WS_GD) + row * 1024 + h * 256; U.Yo = WSB(WS_Y) + row * DM + DSSM + h * 256; U.nq = 128; U.ntiles = 4 * qt + 4; U.nvis_lo = 4 * qt + 2; U.nvis_hi = 4 * qt + 4; U.lk = 1 << 30;
          attn_unit_b(F, U, lam, 1.f - lambda_init, subw, scd); }
        AQ_BOTTOM(); AQ_TOP();
    }
#pragma unroll 1
    while (idx < 144) {
        AQ_ISSUE();
        { float lam = __builtin_bit_cast(float, lam_s); asm volatile("" : "+v"(lam));
          AttnUnit U;
          if (idx < 72) {
            const int su = 8 * x + (idx - 64), b = su >> 2, h = su & 3; const size_t row = (size_t)MP + b * SL;
            U.Q = WSB(WS_QD) + row * 1024 + h * 256; U.K = WSB(WS_KS) + (size_t)b * LKSP * 1024 + h * 256; U.V = WSB(WS_VS) + (size_t)b * LKSP * 1024 + h * 256;
            U.Gt = WSB(WS_GD) + row * 1024 + h * 256; U.Yo = WSB(WS_Y) + row * DM + DSSM + h * 256; U.nq = SL; U.ntiles = (LKS + 31) / 32; U.nvis_lo = U.ntiles; U.nvis_hi = U.ntiles; U.lk = LKS;
            attn_unit<true>(F, U, lam, 1.f - lambda_init, subw, scd); }
          else {
            if (idx < 136) { const int uid = 64 * x + (idx - 72), b = uid >> 7, h = (uid >> 5) & 3, qt = uid & 31; const size_t row = (size_t)b * SEQ + 128 * qt;
                U.Q = WSB(WS_QM) + row * 1024 + h * 256; U.K = WSB(WS_MK) + (size_t)b * NMEM * 1024 + h * 256; U.V = WSB(WS_MV) + (size_t)b * NMEM * 1024 + h * 256;
                U.Gt = WSB(WS_GM) + row * 1024 + h * 256; U.Yo = WSB(WS_Y) + row * DM + DSSM + DDIFF + h * 256; U.nq = 128; }
            else { const int su = 8 * x + (idx - 136), b = su >> 2, h = su & 3; const size_t row = (size_t)MP + b * SL;
                U.Q = WSB(WS_QM) + row * 1024 + h * 256; U.K = WSB(WS_MKS) + (size_t)b * NMEM * 1024 + h * 256; U.V = WSB(WS_MVS) + (size_t)b * NMEM * 1024 + h * 256;
                U.Gt = WSB(WS_GM) + row * 1024 + h * 256; U.Yo = WSB(WS_Y) + row * DM + DSSM + DDIFF + h * 256; U.nq = SL; }
            U.ntiles = NMEM / 32; U.nvis_lo = U.ntiles; U.nvis_hi = U.ntiles; U.lk = 1 << 30;
            attn_unit<false>(F, U, 0.f, 1.f, subw, scm); } }
        AQ_BOTTOM(); AQ_TOP();
    }
#pragma unroll 1
    while (idx < 272) {
        AQ_ISSUE();
        {
            if (!scan_seen) { if (F.tid == 0) { unsigned sp = 0u; while (xb_ld(pbd) < nssd) { __builtin_amdgcn_s_sleep(4); if (++sp > (1u << 24)) break; } __builtin_amdgcn_fence(__ATOMIC_ACQUIRE, "agent"); asm volatile("s_waitcnt vmcnt(0)" ::: "memory"); }
                __syncthreads(); scan_seen = true; }
            const int u = (idx - 144) * 8 + x; ssd_pass_c_prompt(F, layer, u, u + 1, 1); }

        AQ_BOTTOM(); AQ_TOP();
    }
#undef AQ_TOP
#undef AQ_ISSUE
#undef AQ_BOTTOM
}

__device__ __forceinline__ void post_norm_phase(Frame& F, int layer) {
    const int gw = F.bx * NWAVES + F.wave, NGW = F.G * NWAVES, lane = F.lane;
    const float* wpost = INP(10  ) + layer * DM; const float* wpre = INP(9  ) + (layer + 1 < 2 ? layer + 1 : 1) * DM;
    const float* x_prompt = INP(0); const float* x_sample = INP(1);
#pragma unroll 1
    for (int m = gw; m < MT; m += NGW) {
        f32x4 o[16], x[16]; float ss = 0.f;
        if (m < MP) { const GAS v2u* op = (const GAS v2u*)(WSB(WS_HALL) + (size_t)m * DM) + lane;
#pragma unroll
            for (int j = 0; j < 16; ++j) { const v2u q = op[64 * j]; o[j] = (f32x4){bflo(q.x), bfhi(q.x), bflo(q.y), bfhi(q.y)}; } }
        else { const GAS f32x4* op = (const GAS f32x4*)(WSF(WS_O2P) + (size_t)(m - MP) * DM) + lane;
#pragma unroll
            for (int j = 0; j < 16; ++j) o[j] = op[64 * j];
#pragma unroll 1
            for (int sl = 1; sl < 16; ++sl) { op += (size_t)MS * DM / 4;
#pragma unroll
                for (int j = 0; j < 16; ++j) o[j] = o[j] + op[64 * j]; } }
        if (layer == 0) { const GAS f32x4* xr = (const GAS f32x4*)(m < MP ? x_prompt + (size_t)m * DM : x_sample + (size_t)(m - MP) * DM) + lane;
#pragma unroll
            for (int j = 0; j < 16; ++j) x[j] = xr[64 * j]; }
        else { const GAS v2u* xr = (const GAS v2u*)(WSB(WS_X1) + (size_t)m * DM) + lane;
#pragma unroll
            for (int j = 0; j < 16; ++j) { const v2u q = xr[64 * j]; x[j] = (f32x4){bflo(q.x), bfhi(q.x), bflo(q.y), bfhi(q.y)}; } }
#pragma unroll
        for (int j = 0; j < 16; ++j) ss += (o[j].x * o[j].x + o[j].y * o[j].y) + (o[j].z * o[j].z + o[j].w * o[j].w);
        const float rstd = 1.f / sqrtf(wave_sum(ss, lane) * (1.f / DM) + NORM_EPS);
        const GAS f32x4* wp = (const GAS f32x4*)wpost + lane;
        float s2 = 0.f;
#pragma unroll
        for (int j = 0; j < 16; ++j) { const f32x4 ww = wp[64 * j]; x[j] = x[j] + o[j] * rstd * ww; s2 += (x[j].x * x[j].x + x[j].y * x[j].y) + (x[j].z * x[j].z + x[j].w * x[j].w); }
        if (layer == 1) { GAS f32x4* xo = (GAS f32x4*)(F.out + (size_t)m * DM) + lane;
#pragma unroll
            for (int j = 0; j < 16; ++j) xo[64 * j] = x[j]; }
        else { GAS v2u* xo = (GAS v2u*)(WSB(WS_X1) + (size_t)m * DM) + lane;
#pragma unroll
            for (int j = 0; j < 16; ++j) { v2u q; q.x = pk2(x[j].x, x[j].y); q.y = pk2(x[j].z, x[j].w); xo[64 * j] = q; } }
        if (layer == 0) {
            const float r2 = 1.f / sqrtf(wave_sum(s2, lane) * (1.f / DM) + NORM_EPS);
            const GAS f32x4* wq = (const GAS f32x4*)wpre + lane; GAS v2u* ho = (GAS v2u*)(WSB(WS_HALL) + (size_t)m * DM) + lane;
#pragma unroll
            for (int j = 0; j < 16; ++j) { const f32x4 ww = wq[64 * j]; v2u q; q.x = pk2(x[j].x * r2 * ww.x, x[j].y * r2 * ww.y); q.y = pk2(x[j].z * r2 * ww.z, x[j].w * r2 * ww.w); ho[64 * j] = q; }
        }
    }
}

__device__ __forceinline__ void post_norm_sample(Frame& F, int layer) {
    const int lane = F.lane, w = F.wave; volatile LAS float* red = (volatile LAS float*)(F.lds + RING_OFF);
    const float* wpost = INP(10  ) + layer * DM; const float* x_sample = INP(1);
#pragma unroll 1
    for (int r = F.bx; r < MS; r += F.G) {
        const int m = MP + r, c0 = w * 512 + lane * 8;
        const GAS f32x4* op = (const GAS f32x4*)(WSF(WS_O2P) + (size_t)r * DM + c0);
        f32x4 a[16], b[16];
#pragma unroll
        for (int sl = 0; sl < 16; ++sl) { a[sl] = op[(size_t)sl * (MS * DM / 4)]; b[sl] = op[(size_t)sl * (MS * DM / 4) + 1]; }
        f32x4 o0 = a[0], o1 = b[0];
#pragma unroll
        for (int sl = 1; sl < 16; ++sl) { o0 = o0 + a[sl]; o1 = o1 + b[sl]; }
        float ss = ((o0.x * o0.x + o0.y * o0.y) + (o0.z * o0.z + o0.w * o0.w)) + ((o1.x * o1.x + o1.y * o1.y) + (o1.z * o1.z + o1.w * o1.w));
        ss = wave_sum(ss, lane); if (lane == 0) red[w] = ss; LDS_WAIT(); __syncthreads();
        const float tot = ((red[0] + red[1]) + (red[2] + red[3])) + ((red[4] + red[5]) + (red[6] + red[7]));
        const float rstd = 1.f / sqrtf(tot * (1.f / DM) + NORM_EPS);
        f32x4 x0, x1;
        if (layer == 0) { const GAS f32x4* xr = (const GAS f32x4*)(x_sample + (size_t)r * DM + c0); x0 = xr[0]; x1 = xr[1]; }
        else { const v4u q = *(const GAS v4u*)(WSB(WS_HALL) + (size_t)m * DM + c0); x0 = (f32x4){bflo(q.x), bfhi(q.x), bflo(q.y), bfhi(q.y)}; x1 = (f32x4){bflo(q.z), bfhi(q.z), bflo(q.w), bfhi(q.w)}; }
        const GAS f32x4* wp = (const GAS f32x4*)(wpost + c0);
        x0 = x0 + o0 * rstd * wp[0]; x1 = x1 + o1 * rstd * wp[1];
        if (layer == 1) { GAS f32x4* xo = (GAS f32x4*)(F.out + (size_t)m * DM + c0); xo[0] = x0; xo[1] = x1; }
        else {
            v4u q; q.x = pk2(x0.x, x0.y); q.y = pk2(x0.z, x0.w); q.z = pk2(x1.x, x1.y); q.w = pk2(x1.z, x1.w); *(GAS v4u*)(WSB(WS_HALL) + (size_t)m * DM + c0) = q;
            float s2 = ((x0.x * x0.x + x0.y * x0.y) + (x0.z * x0.z + x0.w * x0.w)) + ((x1.x * x1.x + x1.y * x1.y) + (x1.z * x1.z + x1.w * x1.w));
            s2 = wave_sum(s2, lane); if (lane == 0) red[8 + w] = s2; LDS_WAIT(); __syncthreads();
            if (F.tid == 0) { const float t2 = ((red[8] + red[9]) + (red[10] + red[11])) + ((red[12] + red[13]) + (red[14] + red[15])); WSF(WS_RS1)[m] = 1.f / sqrtf(t2 * (1.f / DM) + NORM_EPS); }
        }
        __syncthreads();
    }
    if (layer == 0) {
#pragma unroll 1
        for (int row = F.bx * 512 + F.tid; row < MP; row += F.G * 512) { const GAS f32x4* sp = (const GAS f32x4*)(WSF(WS_XS2) + (size_t)row * 16);
            const f32x4 a = sp[0], b = sp[1], c = sp[2], d = sp[3];
            const float t = (((a.x + a.y) + (a.z + a.w)) + ((b.x + b.y) + (b.z + b.w))) + (((c.x + c.y) + (c.z + c.w)) + ((d.x + d.y) + (d.z + d.w)));
            WSF(WS_RS1)[row] = 1.f / sqrtf(t * (1.f / DM) + NORM_EPS); }
    }
}

#define IN(k) (lo <= (k) && (k) < hi)
#define PHASE_FRAME(P) Frame P = F; asm volatile("" : "+s"(P.wave), "+s"(P.bx), "+s"(P.ws), "+s"(P.out)); P.lane = lane_id_asm(); P.tid = P.wave * 64 + P.lane
#define SEAM(k) do { if (IN(k) && IN((k) + 1)) { int w_ = F.wave; asm volatile("" : "+s"(w_)); xcd_barrier(bar, w_ == 0 && lane_id_asm() == 0); } else __syncthreads(); } while (0)
template <int layer>
__device__ __forceinline__ void layer_phases(Frame& F, const int lo, const int hi, const XcdBarrier& bar) {
        const int pb = 1 + 4 * layer;
        if (IN(pb + 0)) {
            { PHASE_FRAME(P);
            pg8::Gemm g{(const bf16*)(GAS bf16*)(P.ws + WS_HALL), (const bf16*)(GAS bf16*)(P.ws + WS_W1) + (size_t)layer * NW1 * DM, DM, DM};
            Sched1 S{P.G, P.bx, PM_MEM + 4 * layer};
            Epi1 E; E.ws = (unsigned char*)P.ws; E.out = (float*)P.out; E.dt_bias = inp_ptr(P, 14) + layer * NH; E.layer = layer; E.mem_pm0 = PM_MEM + 4 * layer;
            pg8::gemm_phase<Epi1, Sched1>(P.lds + RING_OFF, g, S, E, P.tid); }
            { PHASE_FRAME(P);
              constexpr int NU1 = 65 * 45 + 32; const int rounds = (NU1 + P.G - 1) / P.G, nshort = rounds * P.G - NU1;
              const int nr = nshort == 0 ? P.G : nshort, rank = nshort == 0 ? P.bx : P.bx - (P.G - nshort);
              if (rank >= 0) cache_convert(P, layer, rank, nr); }
            SEAM(pb + 0);
        }
        if (IN(pb + 1)) {
            constexpr int NSSD = 80;
            unsigned* const sbw = (unsigned*)(GAS unsigned*)(F.ws + WS_CTL) + CW_SB + layer * 2 * 64;
            { PHASE_FRAME(P); if (P.bx < NSSD) { P.G = NSSD; conv_phase(P, layer); } }
            if (F.bx < NSSD) { int w_ = F.wave; asm volatile("" : "+s"(w_)); sub_barrier(sbw, NSSD, w_ == 0 && lane_id_asm() == 0); }
            { PHASE_FRAME(P); if (P.bx < NSSD) { ssd_pass_a(P, layer, P.bx, NB * NCH * NG, NSSD); ssd_pass_a(P, layer, NB * NCH * NG + P.bx, NSSD_UNITS, NSSD); } }
            if (F.bx < NSSD) { int w_ = F.wave; asm volatile("" : "+s"(w_)); sub_barrier(sbw + 64, NSSD, w_ == 0 && lane_id_asm() == 0); }
            { PHASE_FRAME(P); if (P.bx < NSSD) { P.G = NSSD; ssd_pass_b(P, layer); } }
            if (F.bx < NSSD) { int w_ = F.wave; asm volatile("" : "+s"(w_)); asm volatile("s_waitcnt vmcnt(0)" ::: "memory"); __syncthreads();
                if (w_ == 0 && lane_id_asm() == 0) { __builtin_amdgcn_fence(__ATOMIC_RELEASE, "agent"); asm volatile("s_waitcnt vmcnt(0)" ::: "memory"); (void)xb_add((unsigned*)(GAS unsigned*)(F.ws + WS_CTL) + CW_PBD + layer * 64, 1u); } }
            { PHASE_FRAME(P); if (P.bx < NSSD) ssd_pass_c(P, layer, NB * NCH * NG + P.bx, NSSD_UNITS, NSSD); }
            { PHASE_FRAME(P); attn_queue(P, layer, (unsigned*)(GAS unsigned*)(P.ws + WS_CTL) + CW_Q + (layer * 8 + (P.bx & 7)) * 64, P.bx & 7, (unsigned*)(GAS unsigned*)(P.ws + WS_CTL) + CW_PBD + layer * 64, NSSD); }
            SEAM(pb + 1);
        }
        if (IN(pb + 2)) {
            { PHASE_FRAME(P); pg8::Gemm g{(const bf16*)(GAS bf16*)(P.ws + WS_Y), (const bf16*)(GAS bf16*)(P.ws + WS_WO) + (size_t)layer * DM * DM, DM, DM}; Sched2F S{P.G, P.bx};
                Epi2F<layer> E; E.ws = (unsigned char*)P.ws; E.out = (float*)P.out; E.wpost = inp_ptr(P, 10) + layer * DM; E.xres = layer == 0 ? inp_ptr(P, 0) : (const float*)(GAS float*)(P.ws + WS_HALL); E.xl = P.lds + RING_OFF + pg8::STAGE_BYTES;
                pg8::gemm_phase<Epi2F<layer>, Sched2F>(P.lds + RING_OFF, g, S, E, P.tid); }
            { PHASE_FRAME(P); pg8::Gemm g{(const bf16*)(GAS bf16*)(P.ws + WS_Y), (const bf16*)(GAS bf16*)(P.ws + WS_WO) + (size_t)layer * DM * DM, DM, 256}; Sched2S S{P.G, P.bx}; Epi2S E{(float*)(GAS float*)(P.ws + WS_O2P)}; pg8::gemm_phase<Epi2S, Sched2S>(P.lds + RING_OFF, g, S, E, P.tid); }
            SEAM(pb + 2);
        }
        if (IN(pb + 3)) { { PHASE_FRAME(P); post_norm_sample(P, layer); } if (layer == 0) SEAM(pb + 3); }
    }
constexpr int NPHASES = 9;
struct Args { const float* in[26]; float* out; unsigned char* ws; int ph_lo, ph_hi; };
static_assert(sizeof(Args) == 26 * 8 + 8 + 8 + 8, "Args has no padding");
__global__ void __launch_bounds__(NWAVES * 64, 2) mk_fwd(Args args) {
    extern __shared__ __attribute__((aligned(16))) unsigned char lds[];
    Frame F;
    F.lds = (LAS unsigned char*)lds;
    F.MISC = (volatile LAS unsigned*)(F.lds + MISC_OFF);
    F.tid = 0; F.lane = 0; F.wave = __builtin_amdgcn_readfirstlane(threadIdx.x >> 6);
    F.G = gridDim.x; F.bx = blockIdx.x;
    F.ws = (GAS unsigned char*)args.ws; F.out = (GAS float*)args.out;
    { const int t0 = threadIdx.x;
    for (int u = t0; u < (LDS_BYTES - LDSCTL_OFF) / 4; u += NWAVES * 64) ((LAS unsigned*)(F.lds + LDSCTL_OFF))[u] = 0u;
    __syncthreads();
    F.tid = t0; }
    if (F.tid < 26) { const unsigned long long p = ((const __attribute__((address_space(4))) unsigned long long*)__builtin_amdgcn_kernarg_segment_ptr())[F.tid];
        ((LAS unsigned*)(F.lds + INP_OFF))[2 * F.tid] = (unsigned)p; ((LAS unsigned*)(F.lds + INP_OFF))[2 * F.tid + 1] = (unsigned)(p >> 32); }
    __syncthreads();
    F.tid = 0;
    const int lo = args.ph_lo, hi = args.ph_hi;
    XcdBarrier bar; bar.bar = (unsigned*)(GAS unsigned*)(F.ws + WS_CTL) + CW_BAR; bar.x = 0; bar.st = nullptr;
    if (hi - lo > 1) { bar.x = xb_xcc_id(); bar.st = F.MISC + 8; if (F.wave == 0 && lane_id_asm() == 0) (void)xb_add(&bar.bar[XB_XCNT(bar.x)], 1u); }

    if (IN(0)) {
#if !(MK_SKIP & 1)
 { PHASE_FRAME(P); p0_prologue(P); }
#if (MK_DUP & 1)
 __syncthreads();
 { PHASE_FRAME(P); p0_prologue(P); }
#endif
#endif
 SEAM(0); }
    layer_phases<0>(F, lo, hi, bar);
    layer_phases<1>(F, lo, hi, bar);
#undef IN
#undef SEAM
}

extern "C" void kernel_launch(void* const* d_in, const int* in_sizes, int n_in, void* d_out, int out_size, void* d_ws, size_t ws_size, hipStream_t stream) {
    static int grid = 0;
    if (grid == 0) {
        if (n_in != 26 || (size_t)out_size != O_END || ws_size < WS_END) { fprintf(stderr, "kernel_launch: unexpected problem (n_in %d, out %d, ws %zu; need ws >= %zu); nothing launched\n", n_in, out_size, ws_size, (size_t)WS_END); grid = -1; return; }
        int dev = 0, cus = 0, per_cu = 0;
        if (hipGetDevice(&dev) != hipSuccess || hipDeviceGetAttribute(&cus, hipDeviceAttributeMultiprocessorCount, dev) != hipSuccess) { grid = -1; return; }
        if (hipFuncSetAttribute((const void*)mk_fwd, hipFuncAttributeMaxDynamicSharedMemorySize, LDS_BYTES) != hipSuccess) { fprintf(stderr, "kernel_launch: hipFuncSetAttribute failed\n"); grid = -1; return; }
        if (hipOccupancyMaxActiveBlocksPerMultiprocessor(&per_cu, (const void*)mk_fwd, NWAVES * 64, LDS_BYTES) != hipSuccess || per_cu < 1)
            fprintf(stderr, "kernel_launch: note: occupancy query reports %d workgroups per CU\n", per_cu);
        (void)hipGetLastError();
        grid = cus;
        if (grid != 256) { fprintf(stderr, "kernel_launch: built for a 256-CU device (the fused GEMM2 epilogue exchanges row statistics between the 256 workgroups of a round); found %d CUs; nothing launched\n", cus); grid = -1; return; }
    }
    if (grid < 0) return;
    if (hipMemsetAsync((char*)d_ws + WS_CTL, 0, CTL_ZERO_BYTES, stream) != hipSuccess) return;
    Args a{};
    for (int i = 0; i < 26; ++i) a.in[i] = (const float*)d_in[i];
    a.out = (float*)d_out; a.ws = (unsigned char*)d_ws;
#if MK_ONE_LAUNCH
    a.ph_lo = 0; a.ph_hi = NPHASES;
    hipLaunchKernelGGL(mk_fwd, dim3(grid), dim3(NWAVES * 64), LDS_BYTES, stream, a);
#else
    for (int k = 0; k < NPHASES; ++k) { a.ph_lo = k; a.ph_hi = k + 1; hipLaunchKernelGGL(mk_fwd, dim3(grid), dim3(NWAVES * 64), LDS_BYTES, stream, a); }
#endif
}
```
